# Optimizing an MI355X kernel written in HIP

```python
import jax, jax.numpy as jnp
from jax import lax
import numpy as np

D_MODEL = 1024
BATCH = 16
SEQ = 2048
DEPTH = 2

RW_HEADS = 8
RW_HEAD_DIM = 64
RW_WIDTH = RW_HEADS * RW_HEAD_DIM
RW_DECAY_LORA = 64
RW_ICLR_LORA = 64
RW_VRES_LORA = 32
RW_GATE_LORA = 160
RW_GN_EPS = 64e-5
RW_SHIFT_COLS = 3 * RW_WIDTH + RW_DECAY_LORA + RW_ICLR_LORA + RW_GATE_LORA
SSM_HEADS = 8
SSM_HEAD_DIM = 64
SSM_WIDTH = SSM_HEADS * SSM_HEAD_DIM
SSM_GROUPS = 2
SSM_STATE = 128
SSM_CONV = 4
SSM_CHUNK = 128
SSM_CONV_CH = SSM_WIDTH + 2 * SSM_GROUPS * SSM_STATE
SSM_COLS = SSM_WIDTH + SSM_CONV_CH + SSM_HEADS
ATT_Q_HEADS = 8
ATT_KV_HEADS = 2
ATT_HEAD_DIM = 64
ATT_WIDTH = ATT_Q_HEADS * ATT_HEAD_DIM
ATT_KV_WIDTH = ATT_KV_HEADS * ATT_HEAD_DIM
ATT_COLS = ATT_WIDTH + 2 * ATT_KV_WIDTH
WINDOW = 128
N_BRANCHES = 3
GATE_COLS = N_BRANCHES * D_MODEL
IN_COLS = RW_SHIFT_COLS + SSM_COLS + ATT_COLS + GATE_COLS
FFN_HIDDEN = 256 * (-(-8 * D_MODEL // (3 * 256)))
NORM_EPS = 1e-6

kernel_name = "hybrid_rwkv7_mamba2_swa_gated_block"


def _split(t, sizes):
    idx = np.cumsum(sizes)[:-1].tolist()
    return jnp.split(t, idx, axis=-1)


def rms_norm(x, w, eps=NORM_EPS):
    xf = x.astype(jnp.float32)
    y = xf * lax.rsqrt(jnp.mean(xf * xf, axis=-1, keepdims=True) + eps)
    return (y * w.astype(jnp.float32)).astype(x.dtype)


def token_shift(p):
    return jnp.pad(p, ((0, 0), (1, 0), (0, 0)))[:, :-1]


def rwkv7_scan(r, decay, k, v, kk, a):
    f32 = jnp.float32
    Bsz, T, H, N = r.shape
    seq = tuple(jnp.moveaxis(t.astype(f32), 1, 0) for t in (r, decay, k, v, kk, a))

    def step(S, inp):
        r_t, w_t, k_t, v_t, kk_t, a_t = inp
        sa = jnp.einsum('bhvk,bhk->bhv', S, -kk_t)
        S = (S * w_t[:, :, None, :]
             + sa[..., None] * (kk_t * a_t)[:, :, None, :]
             + v_t[..., None] * k_t[:, :, None, :])
        return S, jnp.einsum('bhvk,bhk->bhv', S, r_t)

    S0 = jnp.zeros((Bsz, H, N, N), f32)
    _, y = lax.scan(step, S0, seq)
    return jnp.moveaxis(y, 0, 1)


def rwkv7_branch(p_rw, v_first, vres, mu, w0, w2, a0, a2, g2, k_k, k_a, r_k, gn_w, gn_b):
    Bsz, T, _ = p_rw.shape
    p = p_rw + (token_shift(p_rw) - p_rw) * mu
    r, k, v, lw, la, lg = _split(p, [RW_WIDTH] * 3 + [RW_DECAY_LORA, RW_ICLR_LORA, RW_GATE_LORA])
    w = -jax.nn.softplus(-(w0 + jnp.tanh(lw) @ w2)) - 0.5
    decay = jnp.exp(-jnp.exp(w.astype(jnp.float32)))
    a = jax.nn.sigmoid(a0 + la @ a2)
    g = jax.nn.sigmoid(lg) @ g2
    if vres is None:
        v_first = v
    else:
        lv, v0, v2 = vres
        v = v + (v_first - v) * jax.nn.sigmoid(v0 + lv @ v2)
    heads = lambda t: t.reshape(Bsz, T, RW_HEADS, RW_HEAD_DIM)
    kk = heads(k * k_k).astype(jnp.float32)
    kk = kk / jnp.maximum(jnp.sqrt(jnp.sum(kk * kk, axis=-1, keepdims=True)), 1e-12)
    k = k * (1.0 + (a - 1.0) * k_a)
    rh, kh, vh = heads(r), heads(k), heads(v)
    y = rwkv7_scan(rh, heads(decay), kh, vh, kk, heads(a))
    mean = jnp.mean(y, axis=-1, keepdims=True)
    var = jnp.mean(jnp.square(y - mean), axis=-1, keepdims=True)
    y = (y - mean) * lax.rsqrt(var + RW_GN_EPS)
    y = y.reshape(Bsz, T, RW_WIDTH) * gn_w + gn_b
    bonus = jnp.sum(rh * kh * r_k, axis=-1, keepdims=True) * vh
    y = (y + bonus.reshape(Bsz, T, RW_WIDTH)) * g
    return y.astype(p_rw.dtype), v_first


def segsum(a):
    T = a.shape[-1]
    a_rep = jnp.broadcast_to(a[..., None], a.shape + (T,))
    a_rep = jnp.where(jnp.tril(jnp.ones((T, T), bool), -1), a_rep, 0.0)
    s = jnp.cumsum(a_rep, axis=-2)
    return jnp.where(jnp.tril(jnp.ones((T, T), bool), 0), s, -jnp.inf)


def ssd_chunked(x, a, b, c):
    Bsz, T, H, P = x.shape
    N = b.shape[-1]
    Q = SSM_CHUNK
    nc = T // Q
    x = x.reshape(Bsz, nc, Q, H, P)
    b = b.reshape(Bsz, nc, Q, H, N)
    c = c.reshape(Bsz, nc, Q, H, N)
    a = a.reshape(Bsz, nc, Q, H).transpose(0, 3, 1, 2)
    a_cum = jnp.cumsum(a, axis=-1)
    L = jnp.exp(segsum(a))
    cb = jnp.einsum('bclhn,bcshn->bhcls', c, b)
    y_diag = jnp.einsum('bhcls,bcshp->bclhp', cb * L, x)
    decay_states = jnp.exp(a_cum[..., -1:] - a_cum)
    states = jnp.einsum('bclhn,bhcl,bclhp->bchpn', b, decay_states, x)
    states = jnp.concatenate([jnp.zeros_like(states[:, :1]), states], axis=1)
    chunk_decay = jnp.exp(segsum(jnp.pad(a_cum[..., -1], ((0, 0), (0, 0), (1, 0)))))
    states = jnp.einsum('bhzc,bchpn->bzhpn', chunk_decay, states)[:, :-1]
    y_off = jnp.einsum('bclhn,bchpn,bhcl->bclhp', c, states, jnp.exp(a_cum))
    return (y_diag + y_off).reshape(Bsz, T, H, P)


def mamba2_branch(z, xbc, dt_raw, conv_w, conv_b, dt_bias, a_log, d_skip, norm_w):
    Bsz, T, _ = xbc.shape
    conv = lax.conv_general_dilated(
        xbc, conv_w[:, None, :].astype(xbc.dtype), window_strides=(1,),
        padding=[(SSM_CONV - 1, 0)], dimension_numbers=('NWC', 'WIO', 'NWC'),
        feature_group_count=SSM_CONV_CH)
    xbc = jax.nn.silu(conv + conv_b)
    xs, Bm, Cm = _split(xbc, [SSM_WIDTH, SSM_GROUPS * SSM_STATE, SSM_GROUPS * SSM_STATE])
    xs = xs.reshape(Bsz, T, SSM_HEADS, SSM_HEAD_DIM)
    rep = SSM_HEADS // SSM_GROUPS
    Bh = jnp.repeat(Bm.reshape(Bsz, T, SSM_GROUPS, SSM_STATE), rep, axis=2)
    Ch = jnp.repeat(Cm.reshape(Bsz, T, SSM_GROUPS, SSM_STATE), rep, axis=2)
    dt = jax.nn.softplus((dt_raw + dt_bias).astype(jnp.float32))
    A = -jnp.exp(a_log.astype(jnp.float32))
    y = ssd_chunked(xs * dt[..., None], dt * A, Bh, Ch)
    y = y + xs * d_skip[:, None]
    yz = (y.reshape(Bsz, T, SSM_WIDTH) * jax.nn.silu(z)).astype(jnp.float32)
    yz = yz.reshape(Bsz, T, SSM_GROUPS, SSM_WIDTH // SSM_GROUPS)
    yz = yz * lax.rsqrt(jnp.mean(yz * yz, axis=-1, keepdims=True) + NORM_EPS)
    return (yz.reshape(Bsz, T, SSM_WIDTH) * norm_w).astype(xbc.dtype)


def swa_sink_attention(q, k, v, sinks):
    Bsz, T = q.shape[:2]
    W = WINDOW
    nb = T // W
    rep = ATT_Q_HEADS // ATT_KV_HEADS
    q = q.reshape(Bsz, nb, W, ATT_KV_HEADS, rep, ATT_HEAD_DIM)

    def band(t):
        t = t.reshape(Bsz, nb, W, ATT_KV_HEADS, ATT_HEAD_DIM)
        prev = jnp.pad(t, ((0, 0), (1, 0), (0, 0), (0, 0), (0, 0)))[:, :-1]
        return jnp.concatenate([prev, t], axis=2)

    kb, vb = band(k), band(v)
    s = jnp.einsum('bnqgrd,bnkgd->bgrnqk', q, kb).astype(jnp.float32) * (ATT_HEAD_DIM ** -0.5)
    qi = jnp.arange(W)[:, None]
    kj = jnp.arange(2 * W)[None, :]
    rel = qi + W - kj
    blk = jnp.arange(nb)[:, None, None]
    valid = (rel >= 0) & (rel < W) & (blk * W + kj - W >= 0)
    s = jnp.where(valid, s, -jnp.inf)
    sink = jnp.broadcast_to(
        sinks.astype(jnp.float32).reshape(ATT_KV_HEADS, rep)[None, :, :, None, None, None],
        s.shape[:-1] + (1,))
    p = jax.nn.softmax(jnp.concatenate([s, sink], axis=-1), axis=-1)[..., :-1]
    o = jnp.einsum('bgrnqk,bnkgd->bnqgrd', p.astype(vb.dtype), vb)
    return o.reshape(Bsz, T, ATT_WIDTH)


def swiglu(x, w_gu, w_down):
    g, u = jnp.split(x @ w_gu, 2, axis=-1)
    return (jax.nn.silu(g) * u) @ w_down


def setup_inputs(seed: int = 0) -> dict:
    key = jax.random.key(seed)
    keys = jax.random.split(key, 64)
    counter = iter(range(64))
    f32 = jnp.float32

    def nrm(shape, scale):
        return jax.random.normal(keys[next(counter)], shape, f32) * scale

    def uni(shape, lo, hi):
        return jax.random.uniform(keys[next(counter)], shape, f32, lo, hi)

    L, Lv, D = DEPTH, DEPTH - 1, D_MODEL
    dt_init = jnp.exp(uni((L, SSM_HEADS), float(np.log(1e-3)), float(np.log(1e-1))))
    w0_base = jnp.tile(jnp.linspace(-6.5, -1.5, RW_HEAD_DIM, dtype=f32), RW_HEADS)
    return {
        "x": nrm((BATCH, SEQ, D), 1.0),
        "norm_mix": 1.0 + nrm((L, D), 0.02),
        "w_in": nrm((L, D, IN_COLS), D ** -0.5),
        "rw_mu": uni((L, RW_SHIFT_COLS), 0.0, 1.0),
        "rw_w0": w0_base[None] + nrm((L, RW_WIDTH), 0.1),
        "rw_w2": nrm((L, RW_DECAY_LORA, RW_WIDTH), 0.5 * RW_DECAY_LORA ** -0.5),
        "rw_a0": nrm((L, RW_WIDTH), 0.1),
        "rw_a2": nrm((L, RW_ICLR_LORA, RW_WIDTH), 0.5 * RW_ICLR_LORA ** -0.5),
        "rw_g2": nrm((L, RW_GATE_LORA, RW_WIDTH), RW_GATE_LORA ** -0.5),
        "rw_k_k": 0.85 + nrm((L, RW_WIDTH), 0.02),
        "rw_k_a": 1.0 + nrm((L, RW_WIDTH), 0.02),
        "rw_r_k": nrm((L, RW_HEADS, RW_HEAD_DIM), 0.1),
        "rw_gn_w": 1.0 + nrm((L, RW_WIDTH), 0.02),
        "rw_gn_b": nrm((L, RW_WIDTH), 0.02),
        "rw_vres_down": nrm((Lv, D, RW_VRES_LORA), D ** -0.5),
        "rw_vres_mu": uni((Lv, RW_VRES_LORA), 0.0, 1.0),
        "rw_vres_v0": nrm((Lv, RW_WIDTH), 0.5),
        "rw_vres_v2": nrm((Lv, RW_VRES_LORA, RW_WIDTH), RW_VRES_LORA ** -0.5),
        "ssm_conv_w": nrm((L, SSM_CONV, SSM_CONV_CH), SSM_CONV ** -0.5),
        "ssm_conv_b": nrm((L, SSM_CONV_CH), 0.02),
        "ssm_dt_bias": dt_init + jnp.log(-jnp.expm1(-dt_init)),
        "ssm_a_log": jnp.log(uni((L, SSM_HEADS), 1.0, 16.0)),
        "ssm_d": 1.0 + nrm((L, SSM_HEADS), 0.1),
        "ssm_norm_w": 1.0 + nrm((L, SSM_WIDTH), 0.02),
        "att_sinks": nrm((L, ATT_Q_HEADS), 1.0),
        "gate_b": nrm((L, GATE_COLS), 0.1),
        "w_br_rw": nrm((L, RW_WIDTH, D), RW_WIDTH ** -0.5),
        "w_br_ssm": nrm((L, SSM_WIDTH, D), SSM_WIDTH ** -0.5),
        "w_br_att": nrm((L, ATT_WIDTH, D), ATT_WIDTH ** -0.5),
        "w_out": nrm((L, D, D), D ** -0.5),
        "norm_ffn": 1.0 + nrm((L, D), 0.02),
        "ffn_w_gu": nrm((L, D, 2 * FFN_HIDDEN), D ** -0.5),
        "ffn_w_down": nrm((L, FFN_HIDDEN, D), FFN_HIDDEN ** -0.5),
        "norm_final": 1.0 + nrm((D,), 0.02),
    }


def reference(x, norm_mix, w_in, rw_mu, rw_w0, rw_w2, rw_a0, rw_a2, rw_g2, rw_k_k, rw_k_a,
              rw_r_k, rw_gn_w, rw_gn_b, rw_vres_down, rw_vres_mu, rw_vres_v0, rw_vres_v2,
              ssm_conv_w, ssm_conv_b, ssm_dt_bias, ssm_a_log, ssm_d, ssm_norm_w, att_sinks,
              gate_b, w_br_rw, w_br_ssm, w_br_att, w_out, norm_ffn, ffn_w_gu, ffn_w_down,
              norm_final):
    Bsz, T, _ = x.shape
    v_first = None
    for l in range(DEPTH):
        xn = rms_norm(x, norm_mix[l])
        proj = xn @ w_in[l]
        p_rw, p_ssm, p_att, p_gate = _split(proj, [RW_SHIFT_COLS, SSM_COLS, ATT_COLS, GATE_COLS])
        vres = None
        if l > 0:
            lv = xn @ rw_vres_down[l - 1]
            lv = lv + (token_shift(lv) - lv) * rw_vres_mu[l - 1]
            vres = (lv, rw_vres_v0[l - 1], rw_vres_v2[l - 1])
        y_rw, v_first = rwkv7_branch(p_rw, v_first, vres, rw_mu[l], rw_w0[l], rw_w2[l], rw_a0[l],
                                     rw_a2[l], rw_g2[l], rw_k_k[l], rw_k_a[l], rw_r_k[l],
                                     rw_gn_w[l], rw_gn_b[l])
        z, xbc, dt_raw = _split(p_ssm, [SSM_WIDTH, SSM_CONV_CH, SSM_HEADS])
        y_ssm = mamba2_branch(z, xbc, dt_raw, ssm_conv_w[l], ssm_conv_b[l], ssm_dt_bias[l],
                              ssm_a_log[l], ssm_d[l], ssm_norm_w[l])
        q, k, v = _split(p_att, [ATT_WIDTH, ATT_KV_WIDTH, ATT_KV_WIDTH])
        y_att = swa_sink_attention(q.reshape(Bsz, T, ATT_Q_HEADS, ATT_HEAD_DIM),
                                   k.reshape(Bsz, T, ATT_KV_HEADS, ATT_HEAD_DIM),
                                   v.reshape(Bsz, T, ATT_KV_HEADS, ATT_HEAD_DIM), att_sinks[l])
        g_rw, g_ssm, g_att = _split(jax.nn.sigmoid(p_gate + gate_b[l]), [D_MODEL] * N_BRANCHES)
        merged = (g_rw * (y_rw @ w_br_rw[l]) + g_ssm * (y_ssm @ w_br_ssm[l])
                  + g_att * (y_att @ w_br_att[l]))
        x = x + merged @ w_out[l]
        x = x + swiglu(rms_norm(x, norm_ffn[l]), ffn_w_gu[l], ffn_w_down[l])
    return rms_norm(x, norm_final)
```

```cpp
#include <hip/hip_runtime.h>
#include <hip/hip_cooperative_groups.h>
#include <cstdio>
#include <cstdint>
namespace cg = cooperative_groups;

#ifndef MULTI
#define MULTI 0
#endif

typedef unsigned short u16;
typedef short bf16x8 __attribute__((ext_vector_type(8)));
typedef short s16x4 __attribute__((ext_vector_type(4)));
typedef float f32x16 __attribute__((ext_vector_type(16)));
typedef float f32x4 __attribute__((ext_vector_type(4)));
typedef float f32x2 __attribute__((ext_vector_type(2)));
typedef unsigned u32x4 __attribute__((ext_vector_type(4)));

#define DI __device__ __forceinline__
#define MFMA(a, b, c) __builtin_amdgcn_mfma_f32_32x32x16_bf16((a), (b), (c), 0, 0, 0)
#define MFMA16(a, b, c) __builtin_amdgcn_mfma_f32_16x16x32_bf16((a), (b), (c), 0, 0, 0)

constexpr int M_TOK = 32768;
constexpr int SEQ = 2048;
constexpr int DM = 1024;
constexpr int PLD = 4224;
constexpr int C_R = 0, C_K = 512, C_V = 1024, C_LW = 1536, C_LA = 1600, C_LG = 1664;
constexpr int C_LV = 1824, C_Z = 1856, C_XBC = 2368, C_DT = 3392, C_Q = 3456, C_AK = 3968, C_AV = 4096;
constexpr int LALD = 384;
constexpr int XLD = 1088;
constexpr int FH = 2816;
constexpr int SMEM_BYTES = 147456;
constexpr int NTHR = 512;
constexpr int NWV = 8;

struct Params {
  const float* x; const float* norm_mix; const float* w_in; const float* rw_mu; const float* rw_w0; const float* rw_w2;
  const float* rw_a0; const float* rw_a2; const float* rw_g2; const float* rw_k_k; const float* rw_k_a; const float* rw_r_k;
  const float* rw_gn_w; const float* rw_gn_b; const float* vres_down; const float* vres_mu; const float* vres_v0; const float* vres_v2;
  const float* conv_w; const float* conv_b; const float* dt_bias; const float* a_log; const float* ssm_d; const float* ssm_norm_w;
  const float* sinks; const float* gate_b; const float* w_br_rw; const float* w_br_ssm; const float* w_br_att; const float* w_out;
  const float* norm_ffn; const float* w_gu; const float* w_down; const float* norm_final;
  float* out;
  u16 *WinT, *WgT, *WbrT, *WoutT, *w2T, *a2T, *g2T, *v2T, *WguT, *WdownT, *LA, *XN, *PROJ, *VF, *AA, *WR, *GG, *MERGED, *H;
  int* ctr;
};

DI int tidx_() { int t = (int)__builtin_amdgcn_workitem_id_x(); asm volatile("" : "+v"(t)); return t; }
DI int bidx_() { int t = (int)__builtin_amdgcn_workgroup_id_x(); asm volatile("" : "+s"(t)); return t; }
DI int gdim_() { int t = (int)gridDim.x; asm volatile("" : "+s"(t)); return t; }
#define TIDX tidx_()
#define BIDX bidx_()
#define GDIM gdim_()

DI float bf2f(u16 v) { return __uint_as_float(((unsigned)v) << 16); }
DI u16 f2bf(float f) { unsigned u = __float_as_uint(f); u += 0x7fffu + ((u >> 16) & 1u); return (u16)(u >> 16); }
DI unsigned pack2(float a, float b) { return (unsigned)f2bf(a) | ((unsigned)f2bf(b) << 16); }
DI unsigned cvt_pk_bf16(float a, float b) { unsigned r; asm volatile("s_nop 4\n\tv_cvt_pk_bf16_f32 %0, %1, %2\n\ts_nop 1" : "=v"(r) : "v"(a), "v"(b)); return r; }
DI float sigmoidf_(float x) { return __builtin_amdgcn_rcpf(1.f + __expf(-x)); }
DI float siluf_(float x) { return x * sigmoidf_(x); }
DI float tanhf_(float x) { return 1.f - 2.f * __builtin_amdgcn_rcpf(1.f + __expf(2.f * x)); }
DI float softplusf_(float z) { return z > 20.f ? z : __logf(1.f + __expf(z)); }
DI int crow(int r, int h) { return (r & 3) + 8 * (r >> 2) + 4 * h; }
DI float dppf(float x, const int ctrl_sel) {
  int xi = __float_as_int(x);
  int r;
  if (ctrl_sel == 0) r = __builtin_amdgcn_update_dpp(0, xi, 0xB1, 0xF, 0xF, true);
  else if (ctrl_sel == 1) r = __builtin_amdgcn_update_dpp(0, xi, 0x4E, 0xF, 0xF, true);
  else r = __builtin_amdgcn_update_dpp(0, xi, 0x141, 0xF, 0xF, true);
  return __int_as_float(r);
}
DI float red8(float x) {
  x += dppf(x, 0);
  x += dppf(x, 1);
  x += dppf(x, 2);
  return x;
}
DI float wave_sum(float v) {
  v = red8(v);
  v += __int_as_float(__builtin_amdgcn_update_dpp(0, __float_as_int(v), 0x140, 0xF, 0xF, true));
  const float r0 = __int_as_float(__builtin_amdgcn_readlane(__float_as_int(v), 0));
  const float r1 = __int_as_float(__builtin_amdgcn_readlane(__float_as_int(v), 16));
  const float r2 = __int_as_float(__builtin_amdgcn_readlane(__float_as_int(v), 32));
  const float r3 = __int_as_float(__builtin_amdgcn_readlane(__float_as_int(v), 48));
  return (r0 + r1) + (r2 + r3);
}

__device__ void cvt_T(const float* __restrict__ src, int K, int ld, int c0, int ncols, u16* __restrict__ dst, int dld, int r0,
                      int mode, char* smem) {
  float* tl = (float*)smem;
  const int ct = (ncols + 31) >> 5, kt = (K + 63) >> 6;
  const int tid = TIDX;
  const int nt = ct * kt, gd = GDIM;
  const int rk = tid >> 5, rc = tid & 31;
  float v[4];
  auto LOADT = [&](int t) {
    const int cb = (t % ct) * 32, kb = (t / ct) * 64;
#pragma unroll
    for (int i = 0; i < 4; ++i) {
      const int k = rk + 16 * i;
      v[i] = 0.f;
      if (cb + rc < ncols && kb + k < K) v[i] = src[(size_t)(kb + k) * ld + c0 + cb + rc];
    }
  };
  int t = BIDX;
  if (t < nt) LOADT(t);
  for (; t < nt; t += gd) {
    const int cb = (t % ct) * 32, kb = (t / ct) * 64;
    __syncthreads();
#pragma unroll
    for (int i = 0; i < 4; ++i) tl[rc * 65 + rk + 16 * i] = v[i];
    __syncthreads();
    if (t + gd < nt) LOADT(t + gd);
    {
      const int c = tid >> 4, kc = tid & 15;
      if (cb + c < ncols) {
        int drow;
        if (mode == 0) drow = r0 + cb + c;
        else { const int ty = cb >= FH ? 1 : 0; const int j0 = cb - ty * FH; drow = (j0 >> 5) * 64 + ty * 32 + c; }
        const float* sp = tl + c * 65 + kc * 4;
        uint2 o; o.x = pack2(sp[0], sp[1]); o.y = pack2(sp[2], sp[3]);
        *(uint2*)(dst + (size_t)drow * dld + kb + kc * 4) = o;
      }
    }
  }
  __syncthreads();
}

template <int NI>
DI void gemm_core(f32x4 (&acc)[2 * NI][4], const u16* __restrict__ A, int lda, const u16* __restrict__ W, int ldw, int K, char* smem,
                  u32x4 (&ra)[4], u32x4 (&rw)[NI], bool pre, const u16* nA, int nlda, const u16* nW, int nldw) {
  constexpr int A_ELEMS = 256 * 64;
  constexpr int W_ELEMS = 64 * NI * 64;
  u16* As = (u16*)smem;
  u16* Ws = As + 2 * A_ELEMS;
  const int tid = TIDX, lane = tid & 63, wave = tid >> 6;
  const int wm = wave >> 1, wn = wave & 1, fr = lane & 15, fq = lane >> 4;
  const int lr = tid >> 3, lc = tid & 7;
  unsigned opq = 0;
  asm volatile("" : "+v"(opq));
  const u16* ag = A + (size_t)lr * lda + lc * 8 + opq;
  const u16* wg = W + (size_t)lr * ldw + lc * 8 + opq;
  const int sw_st = (lc ^ ((lr >> 1) & 7)) * 8;
  auto GLOAD = [&](int k0) {
#pragma unroll
    for (int i = 0; i < 4; ++i) ra[i] = *(const u32x4*)(ag + (size_t)(64 * i) * lda + k0);
#pragma unroll
    for (int i = 0; i < NI; ++i) rw[i] = *(const u32x4*)(wg + (size_t)(64 * i) * ldw + k0);
  };
  auto GLOADNEXT = [&]() {
    const u16* ag2 = nA + (size_t)lr * nlda + lc * 8 + opq;
    const u16* wg2 = nW + (size_t)lr * nldw + lc * 8 + opq;
#pragma unroll
    for (int i = 0; i < 4; ++i) ra[i] = *(const u32x4*)(ag2 + (size_t)(64 * i) * nlda);
#pragma unroll
    for (int i = 0; i < NI; ++i) rw[i] = *(const u32x4*)(wg2 + (size_t)(64 * i) * nldw);
  };
  auto SSTORE = [&](int buf) {
#pragma unroll
    for (int i = 0; i < 4; ++i) *(u32x4*)(As + buf * A_ELEMS + (lr + 64 * i) * 64 + sw_st) = ra[i];
#pragma unroll
    for (int i = 0; i < NI; ++i) *(u32x4*)(Ws + buf * W_ELEMS + (lr + 64 * i) * 64 + sw_st) = rw[i];
  };
  const int swz = fr >> 1;
  const int off0 = ((0 + fq) ^ swz) * 8, off1 = ((4 + fq) ^ swz) * 8;
  const int KT = K >> 6;
  if (!pre) GLOAD(0);
  SSTORE(0);
  if (KT > 1) GLOAD(64);
  else if (nA) GLOADNEXT();
  __syncthreads();
#pragma unroll 1
  for (int kt = 0; kt < KT; ++kt) {
    const int buf = kt & 1;
    if (kt + 1 < KT) {
      SSTORE(buf ^ 1);
      if (kt + 2 < KT) GLOAD((kt + 2) * 64);
      else if (nA) GLOADNEXT();
    }
    const u16* as = As + buf * A_ELEMS + (wm * 64 + fr) * 64;
    const u16* ws = Ws + buf * W_ELEMS + (wn * 32 * NI + fr) * 64;
#pragma unroll
    for (int ks = 0; ks < 2; ++ks) {
      const int off = ks ? off1 : off0;
      bf16x8 wf[2 * NI], af[4];
#pragma unroll
      for (int nb = 0; nb < 2 * NI; ++nb) wf[nb] = *(const bf16x8*)(ws + nb * 16 * 64 + off);
#pragma unroll
      for (int mb = 0; mb < 4; ++mb) af[mb] = *(const bf16x8*)(as + mb * 16 * 64 + off);
#pragma unroll
      for (int nb = 0; nb < 2 * NI; ++nb)
#pragma unroll
        for (int mb = 0; mb < 4; ++mb) acc[nb][mb] = MFMA16(wf[nb], af[mb], acc[nb][mb]);
    }
    __syncthreads();
  }
}
template <int NI>
DI void gemm_core(f32x4 (&acc)[2 * NI][4], const u16* __restrict__ A, int lda, const u16* __restrict__ W, int ldw, int K, char* smem) {
  u32x4 ra[4], rw[NI];
  gemm_core<NI>(acc, A, lda, W, ldw, K, smem, ra, rw, false, nullptr, 0, nullptr, 0);
}

template <int NI>
DI void zero_acc(f32x4 (&acc)[2 * NI][4]) {
#pragma unroll
  for (int nb = 0; nb < 2 * NI; ++nb)
#pragma unroll
    for (int mb = 0; mb < 4; ++mb) acc[nb][mb] = f32x4{0.f, 0.f, 0.f, 0.f};
}

template <int NI, typename F>
DI void epilogue(f32x4 (&acc)[2 * NI][4], char* smem, F epi) {
  constexpr int SLD = 132;
  float* st = (float*)smem;
  const int tid = TIDX, lane = tid & 63, wave = tid >> 6;
  const int wm = wave >> 1, wn = wave & 1, fr = lane & 15, fq = lane >> 4;
#pragma unroll
  for (int q = 0; q < NI / 2; ++q) {
#pragma unroll
    for (int nn = 0; nn < 4; ++nn)
#pragma unroll
      for (int mb = 0; mb < 4; ++mb)
        *(f32x4*)(st + (wm * 64 + mb * 16 + fr) * SLD + wn * 64 + nn * 16 + fq * 4) = acc[4 * q + nn][mb];
    __syncthreads();
    for (int idx = tid; idx < 256 * 32; idx += NTHR) {
      const int row = idx >> 5, sc = (idx & 31) * 4;
      f32x4 v = *(const f32x4*)(st + row * SLD + sc);
      epi(row, (sc >> 6) * (32 * NI) + q * 64 + (sc & 63), v);
    }
    __syncthreads();
  }
}

DI bool next_tile(int k, int MT, int NT, int& mt, int& nt) {
  const int bid = BIDX, gd = GDIM;
  int tl = (gd == 256) ? k * 256 + (bid & 7) * 32 + (bid >> 3) : k * gd + bid;
  if (tl >= MT * NT) return false;
  const int band = tl / (MT * 8);
  const int w = (NT - band * 8) < 8 ? (NT - band * 8) : 8;
  const int within = tl - band * MT * 8;
  mt = within / w;
  nt = band * 8 + within % w;
  return true;
}

DI void lds_barrier() { asm volatile("s_waitcnt lgkmcnt(0)\n\ts_barrier" ::: "memory"); }

template <int NI, typename F>
DI void epilogue_bf16(f32x4 (&acc)[2 * NI][4], char* smem, u16* dst, int ld, F tr) {
  constexpr int SLD = 264;
  u16* st = (u16*)smem;
  const int tid = TIDX, lane = tid & 63, wave = tid >> 6;
  const int wm = wave >> 1, wn = wave & 1, fr = lane & 15, fq = lane >> 4;
#pragma unroll
  for (int nb = 0; nb < 2 * NI; ++nb)
#pragma unroll
    for (int mb = 0; mb < 4; ++mb) {
      const int row = wm * 64 + mb * 16 + fr, col = wn * 32 * NI + nb * 16 + fq * 4;
      const f32x4 v = tr(row, col, acc[nb][mb]);
      uint2 o; o.x = pack2(v[0], v[1]); o.y = pack2(v[2], v[3]);
      *(uint2*)(st + row * SLD + col) = o;
    }
  lds_barrier();
  constexpr int CH = 8 * NI;
  for (int idx = tid; idx < 256 * CH; idx += NTHR) {
    const int row = idx / CH, ch = idx % CH;
    const u32x4 v = *(const u32x4*)(st + row * SLD + ch * 8);
    *(u32x4*)(dst + (size_t)row * ld + ch * 8) = v;
  }
  lds_barrier();
}

DI void store_bf4(u16* dst, f32x4 v) {
  uint2 o; o.x = pack2(v[0], v[1]); o.y = pack2(v[2], v[3]);
  *(uint2*)dst = o;
}

__device__ void rmsnorm_rows(const float* xin, const float* __restrict__ w, u16* xn, float* copy_to) {
  const int lane = TIDX & 63;
  const int gw = BIDX * NWV + (TIDX >> 6), nw = GDIM * NWV;
  for (int row = gw; row < M_TOK; row += nw) {
    const float* xr = xin + (size_t)row * DM;
    f32x4 v[4];
    float ss = 0.f;
#pragma unroll
    for (int i = 0; i < 4; ++i) {
      v[i] = *(const f32x4*)(xr + i * 256 + lane * 4);
      ss += v[i][0] * v[i][0] + v[i][1] * v[i][1] + v[i][2] * v[i][2] + v[i][3] * v[i][3];
    }
    ss = wave_sum(ss);
    const float rstd = rsqrtf(ss * (1.f / DM) + 1e-6f);
#pragma unroll
    for (int i = 0; i < 4; ++i) {
      const f32x4 ww = *(const f32x4*)(w + i * 256 + lane * 4);
      f32x4 o = {v[i][0] * rstd * ww[0], v[i][1] * rstd * ww[1], v[i][2] * rstd * ww[2], v[i][3] * rstd * ww[3]};
      if (xn) store_bf4(xn + (size_t)row * XLD + i * 256 + lane * 4, o);
      else *(f32x4*)(copy_to + (size_t)row * DM + i * 256 + lane * 4) = o;
      if (xn && copy_to) *(f32x4*)(copy_to + (size_t)row * DM + i * 256 + lane * 4) = v[i];
    }
  }
}

__device__ void phase_A(const Params& p, int l, char* smem) {
  const float* win = p.w_in + (size_t)l * DM * 7208;
  cvt_T(win, 1024, 7208, 0, 1824, p.WinT, XLD, 0, 0, smem);
  cvt_T(win, 1024, 7208, 1824, 1544, p.WinT, XLD, C_Z, 0, smem);
  cvt_T(win, 1024, 7208, 3368, 768, p.WinT, XLD, C_Q, 0, smem);
  if (l == 1) cvt_T(p.vres_down, 1024, 32, 0, 32, p.WinT, XLD, C_LV, 0, smem);
  cvt_T(win, 1024, 7208, 4136, 3072, p.WgT, XLD, 0, 0, smem);
  cvt_T(p.w_br_rw + (size_t)l * 512 * 1024, 512, 1024, 0, 1024, p.WbrT, 512, 0, 0, smem);
  cvt_T(p.w_br_ssm + (size_t)l * 512 * 1024, 512, 1024, 0, 1024, p.WbrT + 1024 * 512, 512, 0, 0, smem);
  cvt_T(p.w_br_att + (size_t)l * 512 * 1024, 512, 1024, 0, 1024, p.WbrT + 2 * 1024 * 512, 512, 0, 0, smem);
  cvt_T(p.w_out + (size_t)l * 1024 * 1024, 1024, 1024, 0, 1024, p.WoutT, XLD, 0, 0, smem);
  cvt_T(p.rw_w2 + (size_t)l * 64 * 512, 64, 512, 0, 512, p.w2T, 64, 0, 0, smem);
  cvt_T(p.rw_a2 + (size_t)l * 64 * 512, 64, 512, 0, 512, p.a2T, 64, 0, 0, smem);
  cvt_T(p.rw_g2 + (size_t)l * 160 * 512, 160, 512, 0, 512, p.g2T, 192, 0, 0, smem);
  if (l == 1) cvt_T(p.vres_v2, 32, 512, 0, 512, p.v2T, 64, 0, 0, smem);
  if (l == 0) rmsnorm_rows(p.x, p.norm_mix, p.XN, p.out);
  else rmsnorm_rows(p.out, p.norm_mix + DM, p.XN, nullptr);
}

__device__ void phase_G1(const Params& p, char* smem) {
  u32x4 ra[4], rw[4];
  bool pre = false;
  int mt, j;
  bool have = next_tile(0, 128, 17, mt, j);
  for (int k = 0; have; ++k) {
    int mt2 = 0, j2 = 0;
    const bool have2 = next_tile(k + 1, 128, 17, mt2, j2);
    const u16* A = p.XN + (size_t)mt * 256 * XLD;
    u16* dst = p.PROJ + (size_t)mt * 256 * PLD + j * 256;
    if (j < 16) {
      const bool nx = have2 && j2 < 16;
      f32x4 acc[8][4];
      zero_acc<4>(acc);
      gemm_core<4>(acc, A, XLD, p.WinT + (size_t)j * 256 * XLD, XLD, DM, smem, ra, rw, pre,
                   nx ? p.XN + (size_t)mt2 * 256 * XLD : nullptr, XLD, p.WinT + (size_t)j2 * 256 * XLD, XLD);
      pre = nx;
      epilogue_bf16<4>(acc, smem, dst, PLD, [&](int, int, f32x4 v) { return v; });
    } else {
      f32x4 acc[4][4];
      zero_acc<2>(acc);
      gemm_core<2>(acc, A, XLD, p.WinT + (size_t)j * 256 * XLD, XLD, DM, smem);
      pre = false;
      epilogue_bf16<2>(acc, smem, dst, PLD, [&](int, int, f32x4 v) { return v; });
    }
    mt = mt2; j = j2; have = have2;
  }
}

__device__ void phase_pre(const Params& p, int l) {
  const int lane = TIDX & 63;
  const int gw = BIDX * NWV + (TIDX >> 6), nw = GDIM * NWV;
  const float* mu = p.rw_mu + l * 1824;
  for (int row = gw; row < M_TOK; row += nw) {
    const bool hp = (row & (SEQ - 1)) != 0;
    const u16* pr = p.PROJ + (size_t)row * PLD;
    const u16* pp = pr - PLD;
    u16* la = p.LA + (size_t)row * LALD;
    auto mix = [&](int colp, float m) {
      const float a = bf2f(pr[colp]);
      const float b = hp ? bf2f(pp[colp]) : 0.f;
      return a + (b - a) * m;
    };
    la[lane] = f2bf(tanhf_(mix(C_LW + lane, mu[C_LW + lane])));
    la[64 + lane] = f2bf(mix(C_LA + lane, mu[C_LA + lane]));
    la[128 + lane] = f2bf(sigmoidf_(mix(C_LG + lane, mu[C_LG + lane])));
    la[192 + lane] = f2bf(sigmoidf_(mix(C_LG + 64 + lane, mu[C_LG + 64 + lane])));
    u16 e4 = 0;
    if (lane < 32) e4 = f2bf(sigmoidf_(mix(C_LG + 128 + lane, mu[C_LG + 128 + lane])));
    la[256 + lane] = e4;
    u16 e5 = 0;
    if (l == 1 && lane < 32) e5 = f2bf(mix(C_LV + lane, p.vres_mu[lane]));
    la[320 + lane] = e5;
    if (l == 0) {
#pragma unroll
      for (int j = 0; j < 8; ++j) {
        const int c = lane + 64 * j;
        p.VF[(size_t)row * 512 + c] = f2bf(mix(C_V + c, mu[C_V + c]));
      }
    }
  }
}

__device__ void phase_prep(const Params& p, int l, char* smem) {
  const int nk = (l == 1) ? 4 : 3;
  for (int k = 0;; ++k) {
    int mt, kn;
    if (!next_tile(k, 128, 2 * nk, mt, kn)) break;
    const int kind = kn >> 1, nt = kn & 1;
    const int koff = kind == 0 ? 0 : (kind == 1 ? 64 : (kind == 2 ? 128 : 320));
    const int Kk = kind == 2 ? 192 : 64;
    const u16* Wk = kind == 0 ? p.w2T : (kind == 1 ? p.a2T : (kind == 2 ? p.g2T : p.v2T));
    f32x4 acc[8][4];
    zero_acc<4>(acc);
    gemm_core<4>(acc, p.LA + (size_t)mt * 256 * LALD + koff, LALD, Wk + (size_t)nt * 256 * Kk, Kk, Kk, smem);
    const int m0 = mt * 256, n0 = nt * 256;
    if (kind == 0) {
      const float* w0 = p.rw_w0 + l * 512 + n0;
      epilogue_bf16<4>(acc, smem, p.WR + (size_t)m0 * 512 + n0, 512, [&](int, int col, f32x4 v) {
        const f32x4 b = *(const f32x4*)(w0 + col);
        f32x4 o = {v[0] + b[0], v[1] + b[1], v[2] + b[2], v[3] + b[3]};
        return o;
      });
    } else if (kind == 1) {
      const float* a0 = p.rw_a0 + l * 512 + n0;
      epilogue_bf16<4>(acc, smem, p.AA + (size_t)m0 * 512 + n0, 512, [&](int, int col, f32x4 v) {
        const f32x4 b = *(const f32x4*)(a0 + col);
        f32x4 o = {sigmoidf_(v[0] + b[0]), sigmoidf_(v[1] + b[1]), sigmoidf_(v[2] + b[2]), sigmoidf_(v[3] + b[3])};
        return o;
      });
    } else if (kind == 2) {
      epilogue_bf16<4>(acc, smem, p.GG + (size_t)m0 * 512 + n0, 512, [&](int, int, f32x4 v) { return v; });
    } else {
      const float* v0 = p.vres_v0 + n0;
      const float* mu = p.rw_mu + l * 1824 + C_V + n0;
      epilogue<4>(acc, smem, [&](int row, int col, f32x4 v) {
        const int m = m0 + row;
        const bool hp = (m & (SEQ - 1)) != 0;
        const u16* pr = p.PROJ + (size_t)m * PLD + C_V + n0 + col;
        u16* vf = p.VF + (size_t)m * 512 + n0 + col;
        f32x4 o;
#pragma unroll
        for (int j = 0; j < 4; ++j) {
          const float a = bf2f(pr[j]);
          const float b = hp ? bf2f(pr[j - PLD]) : 0.f;
          const float vv = a + (b - a) * mu[col + j];
          const float gate = sigmoidf_(v0[col + j] + v[j]);
          const float f = bf2f(vf[j]);
          o[j] = vv + (f - vv) * gate;
        }
        store_bf4(vf, o);
      });
    }
  }
}

__device__ void rwkv_item(const Params& p, int l, int item, char* smem, int dry) {
  const int b = item >> 3, hh = item & 7;
  const int tid = TIDX, lane = tid & 63, wave = tid >> 6;
  float* stg = (float*)smem;
  float* ybuf = stg + 2 * 16 * 448;
  float* bon = ybuf + 16 * 64;
  const int col = hh * 64 + lane;
  const float mu_r = p.rw_mu[l * 1824 + C_R + col], mu_k = p.rw_mu[l * 1824 + C_K + col];
  const float kk_w = p.rw_k_k[l * 512 + col], ka_w = p.rw_k_a[l * 512 + col], rk_w = p.rw_r_k[l * 512 + col];
  const float gnw = p.rw_gn_w[l * 512 + col], gnb = p.rw_gn_b[l * 512 + col];
  const size_t row0 = (size_t)b * SEQ;
  const int r0 = wave * 8 + (lane >> 3), c = lane & 7;
  float S0[8];
#pragma unroll
  for (int i = 0; i < 8; ++i) S0[i] = 0.f;
  u16 q_rt[2], q_rp[2], q_kt[2], q_kp[2], q_v[2], q_a[2], q_w[2], q_g[2];
#define RW_LOAD(t0)                                                                                 \
  {                                                                                                 \
    int pin_ = 1;                                                                                   \
    asm volatile("" : "+s"(pin_));                                                                  \
    _Pragma("unroll") for (int i = 0; i < 2; ++i) {                                                 \
      q_rt[i] = 0; q_kt[i] = 0; q_rp[i] = 0; q_kp[i] = 0; q_v[i] = 0; q_a[i] = 0; q_w[i] = 0; q_g[i] = 0; \
    }                                                                                               \
    if (pin_) {                                                                                     \
    _Pragma("unroll") for (int i = 0; i < 2; ++i) {                                                 \
      const int t = (t0) + wave + 8 * i;                                                            \
      const size_t row = row0 + t;                                                                  \
      const u16* pr = p.PROJ + row * PLD;                                                           \
      q_rt[i] = pr[C_R + col]; q_kt[i] = pr[C_K + col];                                             \
      q_rp[i] = t > 0 ? pr[C_R + col - PLD] : (u16)0; q_kp[i] = t > 0 ? pr[C_K + col - PLD] : (u16)0; \
      q_v[i] = p.VF[row * 512 + col]; q_a[i] = p.AA[row * 512 + col];                               \
      q_w[i] = p.WR[row * 512 + col]; q_g[i] = p.GG[row * 512 + col];                               \
    }                                                                                               \
    }                                                                                               \
  }
#define RW_FILL(buf)                                                                                \
  {                                                                                                 \
    _Pragma("unroll") for (int i = 0; i < 2; ++i) {                                                 \
      const int tt = wave + 8 * i;                                                                  \
      const float rt = bf2f(q_rt[i]), kt_ = bf2f(q_kt[i]);                                          \
      const float r = rt + (bf2f(q_rp[i]) - rt) * mu_r;                                             \
      const float kx = kt_ + (bf2f(q_kp[i]) - kt_) * mu_k;                                          \
      const float aa = bf2f(q_a[i]);                                                                \
      const float kkv = kx * kk_w;                                                                  \
      const float nrm = sqrtf(wave_sum(kkv * kkv));                                                 \
      const float kkn = kkv / fmaxf(nrm, 1e-12f);                                                   \
      const float knew = kx * (1.f + (aa - 1.f) * ka_w);                                            \
      const float wl = -softplusf_(-bf2f(q_w[i])) - 0.5f;                                           \
      const float wdec = __expf(-__expf(wl));                                                       \
      float* s = stg + ((buf) * 16 + tt) * 448;                                                     \
      s[lane] = r; s[64 + lane] = wdec; s[128 + lane] = knew; s[192 + lane] = -kkn;                 \
      s[256 + lane] = kkn * aa; s[320 + lane] = bf2f(q_v[i]); s[384 + lane] = bf2f(q_g[i]);         \
      const float bs = wave_sum(r * knew * rk_w);                                                   \
      if (lane == 0) bon[(buf) * 16 + tt] = bs;                                                     \
    }                                                                                               \
  }
  __syncthreads();
  RW_LOAD(0);
  RW_FILL(0);
  __syncthreads();
  for (int ch = 0; ch < SEQ / 16; ++ch) {
    const int buf = ch & 1, t0 = ch * 16;
    {
    if (ch + 1 < SEQ / 16) RW_LOAD(t0 + 16);
    {
      f32x4 op[2][10];
      float ov[2];
      const float* sb = stg + buf * 16 * 448 + c * 8;
#define RW_LDOPS(tt, q)                                                        \
      {                                                                        \
        const float* s_ = sb + (tt) * 448;                                     \
        _Pragma("unroll") for (int u = 0; u < 5; ++u) {                        \
          op[q][2 * u] = *(const f32x4*)(s_ + 64 * u);                         \
          op[q][2 * u + 1] = *(const f32x4*)(s_ + 64 * u + 4);                 \
        }                                                                      \
        ov[q] = stg[(buf * 16 + (tt)) * 448 + 320 + r0];                       \
      }
      RW_LDOPS(0, 0);
#pragma unroll 1
      for (int t2 = 0; t2 < 16; t2 += 2) {
#pragma unroll
      for (int q = 0; q < 2; ++q) {
        const int tt = t2 + q;
        if (q == 0) RW_LDOPS(tt + 1, 1) else if (t2 + 2 < 16) RW_LDOPS(tt + 1, 0);
        float sa_e = 0.f, sa_o = 0.f;
#pragma unroll
        for (int i = 0; i < 4; ++i) {
          sa_e += S0[i] * op[q][6][i];
          sa_o += S0[4 + i] * op[q][7][i];
        }
        const float sa0 = red8(sa_e + sa_o);
        const float vv = ov[q];
        float y_e = 0.f, y_o = 0.f;
#pragma unroll
        for (int i = 0; i < 4; ++i) {
          S0[i] = S0[i] * op[q][2][i] + sa0 * op[q][8][i] + vv * op[q][4][i];
          S0[4 + i] = S0[4 + i] * op[q][3][i] + sa0 * op[q][9][i] + vv * op[q][5][i];
          y_e += S0[i] * op[q][0][i];
          y_o += S0[4 + i] * op[q][1][i];
        }
        const float yy = red8(y_e + y_o);
        if (c == 0) ybuf[tt * 64 + r0] = yy;
      }
      }
#undef RW_LDOPS
    }
    }
    __syncthreads();
    {
#pragma unroll
    for (int i = 0; i < 2; ++i) {
      const int tt = wave + 8 * i;
      const float y = ybuf[tt * 64 + lane];
      const float mean = wave_sum(y) * (1.f / 64.f);
      const float d = y - mean;
      const float var = wave_sum(d * d) * (1.f / 64.f);
      const float yn = d * rsqrtf(var + 64e-5f) * gnw + gnb;
      const float* s = stg + (buf * 16 + tt) * 448;
      const float o = (yn + bon[buf * 16 + tt] * s[320 + lane]) * s[384 + lane];
      if (!dry) p.GG[(row0 + t0 + tt) * 512 + col] = f2bf(o);
    }
    if (ch + 1 < SEQ / 16) RW_FILL(buf ^ 1);
    }
    __syncthreads();
  }
#undef RW_LOAD
#undef RW_FILL
}

__device__ void ssd_item(const Params& p, int l, int item, char* smem, int dry) {
  const int b = item >> 3, hh = item & 7, g = hh >> 2;
  const int tid = TIDX, lane = tid & 63, wave = tid >> 6;
  constexpr int SS = 456;
  float* stg = (float*)smem;
  float* ybuf = stg + 2 * 16 * SS;
  int chn[5] = {hh * 64 + lane, 512 + g * 128 + lane, 512 + g * 128 + 64 + lane, 768 + g * 128 + lane, 768 + g * 128 + 64 + lane};
  float cw[4][5], cbv[5];
#pragma unroll
  for (int k = 0; k < 5; ++k) {
    cbv[k] = p.conv_b[l * 1024 + chn[k]];
#pragma unroll
    for (int j = 0; j < 4; ++j) cw[j][k] = p.conv_w[(l * 4 + j) * 1024 + chn[k]];
  }
  const float dtb = p.dt_bias[l * 8 + hh];
  const float Aneg = -__expf(p.a_log[l * 8 + hh]);
  const float Dsk = p.ssm_d[l * 8 + hh];
  const size_t row0 = (size_t)b * SEQ;
  const int r0 = tid >> 3, c = tid & 7;
  float S0[16];
#pragma unroll
  for (int i = 0; i < 16; ++i) S0[i] = 0.f;
  u16 q_x[5][5], q_z[2], q_dt[2];
#define SSD_LOAD(t0)                                                                   \
  {                                                                                    \
    _Pragma("unroll") for (int k = 0; k < 5; ++k) {                                    \
      const int t = (t0) + 2 * wave - 3 + k;                                           \
      const u16* pr = p.PROJ + (row0 + (t < 0 ? 0 : t)) * PLD + C_XBC;                 \
      _Pragma("unroll") for (int j = 0; j < 5; ++j) q_x[k][j] = t >= 0 ? pr[chn[j]] : (u16)0; \
    }                                                                                  \
    int pin_ = 1;                                                                      \
    asm volatile("" : "+s"(pin_));                                                     \
    q_z[0] = 0; q_z[1] = 0; q_dt[0] = 0; q_dt[1] = 0;                                  \
    if (pin_) {                                                                        \
    _Pragma("unroll") for (int i = 0; i < 2; ++i) {                                    \
      const u16* pr = p.PROJ + (row0 + (t0) + 2 * wave + i) * PLD;                     \
      q_z[i] = pr[C_Z + hh * 64 + lane]; q_dt[i] = pr[C_DT + hh];                      \
    }                                                                                  \
    }                                                                                  \
  }
#define SSD_FILL(buf)                                                                  \
  {                                                                                    \
    _Pragma("unroll") for (int i = 0; i < 2; ++i) {                                    \
      float cv[5];                                                                     \
      _Pragma("unroll") for (int j = 0; j < 5; ++j) {                                  \
        float a = cbv[j];                                                              \
        _Pragma("unroll") for (int k = 0; k < 4; ++k) a += cw[k][j] * bf2f(q_x[i + k][j]); \
        cv[j] = siluf_(a);                                                             \
      }                                                                                \
      const float dt = softplusf_(bf2f(q_dt[i]) + dtb);                                \
      float* s = stg + ((buf) * 16 + 2 * wave + i) * SS;                               \
      s[lane] = cv[1]; s[64 + lane] = cv[2]; s[128 + lane] = cv[3]; s[192 + lane] = cv[4]; \
      s[256 + lane] = cv[0] * dt; s[320 + lane] = cv[0]; s[384 + lane] = bf2f(q_z[i]); \
      if (lane == 0) s[448] = __expf(dt * Aneg);                                       \
    }                                                                                  \
  }
  __syncthreads();
  SSD_LOAD(0);
  SSD_FILL(0);
  __syncthreads();
  for (int ch = 0; ch < SEQ / 16; ++ch) {
    const int buf = ch & 1, t0 = ch * 16;
    {
    if (ch + 1 < SEQ / 16) SSD_LOAD(t0 + 16);
    {
      f32x4 op[2][8];
      float oxd[2], oda[2];
      const float* sb = stg + buf * 16 * SS;
#define SSD_LDOPS(tt, q)                                                       \
      {                                                                        \
        const float* s_ = sb + (tt) * SS;                                      \
        _Pragma("unroll") for (int u = 0; u < 4; ++u) {                        \
          op[q][u] = *(const f32x4*)(s_ + c * 16 + u * 4);                     \
          op[q][4 + u] = *(const f32x4*)(s_ + 128 + c * 16 + u * 4);           \
        }                                                                      \
        oxd[q] = s_[256 + r0];                                                 \
        oda[q] = s_[448];                                                      \
      }
      SSD_LDOPS(0, 0);
#pragma unroll 1
      for (int t2 = 0; t2 < 16; t2 += 2) {
#pragma unroll
      for (int q = 0; q < 2; ++q) {
        const int tt = t2 + q;
        if (q == 0) SSD_LDOPS(tt + 1, 1) else if (t2 + 2 < 16) SSD_LDOPS(tt + 1, 0);
        const float dA = oda[q], xd = oxd[q];
        float y_e = 0.f, y_o = 0.f;
#pragma unroll
        for (int u = 0; u < 4; ++u)
#pragma unroll
          for (int j = 0; j < 4; ++j) {
            S0[u * 4 + j] = S0[u * 4 + j] * dA + xd * op[q][u][j];
            if (u & 1) y_o += S0[u * 4 + j] * op[q][4 + u][j];
            else y_e += S0[u * 4 + j] * op[q][4 + u][j];
          }
        const float yy = red8(y_e + y_o);
        if (c == 0) ybuf[tt * 64 + r0] = yy;
      }
      }
#undef SSD_LDOPS
    }
    }
    __syncthreads();
    {
#pragma unroll
    for (int i = 0; i < 2; ++i) {
      const int tt = wave + 8 * i;
      const float* s = stg + (buf * 16 + tt) * SS;
      const float y = ybuf[tt * 64 + lane] + Dsk * s[320 + lane];
      const float zz = s[384 + lane];
      if (!dry) p.PROJ[(row0 + t0 + tt) * PLD + C_Z + hh * 64 + lane] = f2bf(y * siluf_(zz));
    }
    if (ch + 1 < SEQ / 16) SSD_FILL(buf ^ 1);
    }
    __syncthreads();
  }
#undef SSD_LOAD
#undef SSD_FILL
}

__device__ void attn_item(const Params& p, int l, int item, char* smem, int dry) {
  const int hp = item & 3, qb = (item >> 2) & 15, b = item >> 6;
  const int kvh = hp >> 1;
  u16* Ks = (u16*)smem;
  u16* Vt = (u16*)(smem + 256 * 72 * 2);
  float* invd = (float*)(smem + 256 * 72 * 2 + 64 * 264 * 2);
  const int tid = TIDX, lane = tid & 63, wave = tid >> 6, wq = wave & 3, l31 = lane & 31, h = lane >> 5;
  const int hq = hp * 2 + (wave >> 2);
  const size_t rowq0 = (size_t)b * SEQ + qb * 128;
  const long rowk0 = (long)rowq0 - 128;
  __syncthreads();
#pragma unroll
  for (int i = 0; i < 4; ++i) {
    const int cidx = tid + NTHR * i;
    const int key = cidx >> 3, cc = cidx & 7;
    uint4 v = {0u, 0u, 0u, 0u};
    if (qb > 0 || key >= 128) v = *(const uint4*)(p.PROJ + (size_t)(rowk0 + key) * PLD + C_AK + kvh * 64 + cc * 8);
    *(uint4*)(Ks + key * 72 + cc * 8) = v;
  }
#pragma unroll
  for (int i = 0; i < 4; ++i) {
    const int key = (tid & 63) + 64 * i;
    const int dc = tid >> 6;
    uint4 v = {0u, 0u, 0u, 0u};
    if (qb > 0 || key >= 128) v = *(const uint4*)(p.PROJ + (size_t)(rowk0 + key) * PLD + C_AV + kvh * 64 + dc * 8);
    const unsigned e[4] = {v.x, v.y, v.z, v.w};
#pragma unroll
    for (int j = 0; j < 4; ++j) {
      Vt[(dc * 8 + 2 * j) * 264 + key] = (u16)(e[j] & 0xffffu);
      Vt[(dc * 8 + 2 * j + 1) * 264 + key] = (u16)(e[j] >> 16);
    }
  }
  __syncthreads();
  const u16* qptr = p.PROJ + (rowq0 + wq * 32 + l31) * PLD + C_Q + hq * 64 + h * 8;
  bf16x8 qf[4];
#pragma unroll
  for (int ks = 0; ks < 4; ++ks) qf[ks] = *(const bf16x8*)(qptr + ks * 16);
  f32x16 sc[5];
#pragma unroll
  for (int i = 0; i < 5; ++i) {
#pragma unroll
    for (int r = 0; r < 16; ++r) sc[i][r] = 0.f;
    const u16* kp = Ks + ((wq + i) * 32 + l31) * 72 + h * 8;
#pragma unroll
    for (int ks = 0; ks < 4; ++ks) {
      const bf16x8 kf = *(const bf16x8*)(kp + ks * 16);
      sc[i] = MFMA(kf, qf[ks], sc[i]);
    }
  }
  const int qi = wq * 32 + l31;
  const float sink = p.sinks[l * 8 + hq];
  float m = sink;
#pragma unroll
  for (int i = 0; i < 5; ++i)
#pragma unroll
    for (int r = 0; r < 16; ++r) {
      const int j = (wq + i) * 32 + crow(r, h);
      const int rel = qi + 128 - j;
      const bool valid = (rel >= 0) && (rel < 128) && (qb > 0 || j >= 128);
      const float s = valid ? sc[i][r] * 0.125f : -INFINITY;
      sc[i][r] = s;
      m = fmaxf(m, s);
    }
  m = fmaxf(m, __shfl_xor(m, 32));
  float sum = 0.f;
#pragma unroll
  for (int i = 0; i < 5; ++i)
#pragma unroll
    for (int r = 0; r < 16; ++r) {
      const float pv = __expf(sc[i][r] - m);
      sc[i][r] = pv;
      sum += pv;
    }
  sum += __shfl_xor(sum, 32);
  const float denom = sum + __expf(sink - m);
  if (h == 0) invd[(wave >> 2) * 128 + qi] = 1.f / denom;
  f32x16 o[2];
#pragma unroll
  for (int db = 0; db < 2; ++db)
#pragma unroll
    for (int r = 0; r < 16; ++r) o[db][r] = 0.f;
#pragma unroll
  for (int i = 0; i < 5; ++i)
#pragma unroll
    for (int s2 = 0; s2 < 2; ++s2) {
      bf16x8 pa;
#pragma unroll
      for (int j = 0; j < 8; ++j) pa[j] = (short)f2bf(sc[i][8 * s2 + j]);
#pragma unroll
      for (int db = 0; db < 2; ++db) {
        const u16* vp = Vt + (db * 32 + l31) * 264 + (wq + i) * 32 + 16 * s2 + 4 * h;
        const s16x4 lo = *(const s16x4*)vp;
        const s16x4 hi = *(const s16x4*)(vp + 8);
        const bf16x8 vf = __builtin_shufflevector(lo, hi, 0, 1, 2, 3, 4, 5, 6, 7);
        o[db] = MFMA(pa, vf, o[db]);
      }
    }
  __syncthreads();
#pragma unroll
  for (int db = 0; db < 2; ++db)
#pragma unroll
    for (int r = 0; r < 16; ++r) {
      const int q = wq * 32 + crow(r, h);
      if (!dry) p.PROJ[(rowq0 + q) * PLD + C_Q + hq * 64 + db * 32 + l31] = f2bf(o[db][r] * invd[(wave >> 2) * 128 + q]);
    }
}

__device__ void phase_attn(const Params& p, int l, char* smem, int dry) {
  for (int it = BIDX; it < 1024; it += GDIM) attn_item(p, l, it, smem, dry);
}
__device__ void phase_mix(const Params& p, int l, char* smem, int dry) {
  for (int it = BIDX; it < 256; it += GDIM) {
    if (it < 128) rwkv_item(p, l, it, smem, dry);
    else ssd_item(p, l, it - 128, smem, dry);
  }
}

__device__ void phase_post(const Params& p, int l, char* smem) {
  cvt_T(p.w_gu + (size_t)l * DM * 2 * FH, 1024, 2 * FH, 0, 2 * FH, p.WguT, XLD, 0, 1, smem);
  cvt_T(p.w_down + (size_t)l * FH * DM, FH, 1024, 0, 1024, p.WdownT, FH, 0, 0, smem);
  const int lane = TIDX & 63;
  const int gw = BIDX * NWV + (TIDX >> 6), nw = GDIM * NWV;
  const float* nwp = p.ssm_norm_w + l * 512 + lane * 8;
  for (int row = gw; row < M_TOK; row += nw) {
    u16* pz = p.PROJ + (size_t)row * PLD + C_Z + lane * 8;
    const uint4 raw = *(const uint4*)pz;
    const unsigned e[4] = {raw.x, raw.y, raw.z, raw.w};
    float v[8];
    float ss = 0.f;
#pragma unroll
    for (int j = 0; j < 4; ++j) {
      v[2 * j] = bf2f((u16)(e[j] & 0xffffu));
      v[2 * j + 1] = bf2f((u16)(e[j] >> 16));
      ss += v[2 * j] * v[2 * j] + v[2 * j + 1] * v[2 * j + 1];
    }
#pragma unroll
    for (int o = 16; o > 0; o >>= 1) ss += __shfl_xor(ss, o);
    const float rstd = rsqrtf(ss * (1.f / 256.f) + 1e-6f);
    uint4 ov;
    ov.x = pack2(v[0] * rstd * nwp[0], v[1] * rstd * nwp[1]);
    ov.y = pack2(v[2] * rstd * nwp[2], v[3] * rstd * nwp[3]);
    ov.z = pack2(v[4] * rstd * nwp[4], v[5] * rstd * nwp[5]);
    ov.w = pack2(v[6] * rstd * nwp[6], v[7] * rstd * nwp[7]);
    *(uint4*)pz = ov;
  }
}

__device__ void phase_G2(const Params& p, int l, char* smem) {
  const int lane = TIDX & 63, wave = TIDX >> 6, wn = wave & 1, fq = lane >> 4;
  u32x4 ra[4], rw[2];
  bool pre = false;
  int mt, nt;
  bool have = next_tile(0, 128, 8, mt, nt);
  for (int k = 0; have; ++k) {
    int mt2 = 0, nt2 = 0;
    const bool have2 = next_tile(k + 1, 128, 8, mt2, nt2);
    const int m0 = mt * 256, n0 = nt * 128;
    f32x4 tot[4][4];
    zero_acc<2>(tot);
#pragma unroll 1
    for (int br = 0; br < 3; ++br) {
      const u16* Ab; int lda;
      if (br == 0) { Ab = p.GG + (size_t)m0 * 512; lda = 512; }
      else if (br == 1) { Ab = p.PROJ + (size_t)m0 * PLD + C_Z; lda = PLD; }
      else { Ab = p.PROJ + (size_t)m0 * PLD + C_Q; lda = PLD; }
      const u16* Wb = p.WbrT + ((size_t)br * 1024 + n0) * 512;
      f32x4 ac[4][4];
      zero_acc<2>(ac);
      gemm_core<2>(ac, p.XN + (size_t)m0 * XLD, XLD, p.WgT + ((size_t)br * 1024 + n0) * XLD, XLD, DM, smem, ra, rw, pre,
                   Ab, lda, Wb, 512);
      unsigned sg[4][4][2];
      const float* gb = p.gate_b + l * 3072 + br * 1024 + n0 + wn * 64 + fq * 4;
#pragma unroll
      for (int nb = 0; nb < 4; ++nb) {
        const f32x4 bias = *(const f32x4*)(gb + nb * 16);
#pragma unroll
        for (int mb = 0; mb < 4; ++mb) {
          sg[nb][mb][0] = cvt_pk_bf16(sigmoidf_(ac[nb][mb][0] + bias[0]), sigmoidf_(ac[nb][mb][1] + bias[1]));
          sg[nb][mb][1] = cvt_pk_bf16(sigmoidf_(ac[nb][mb][2] + bias[2]), sigmoidf_(ac[nb][mb][3] + bias[3]));
        }
      }
      zero_acc<2>(ac);
      const bool more = br < 2 || have2;
      const int m0n = br < 2 ? m0 : mt2 * 256, n0n = br < 2 ? n0 : nt2 * 128, brn = br < 2 ? br + 1 : 0;
      gemm_core<2>(ac, Ab, lda, Wb, 512, 512, smem, ra, rw, true,
                   more ? p.XN + (size_t)m0n * XLD : nullptr, XLD, p.WgT + ((size_t)brn * 1024 + n0n) * XLD, XLD);
      pre = more;
#pragma unroll
      for (int nb = 0; nb < 4; ++nb)
#pragma unroll
        for (int mb = 0; mb < 4; ++mb) {
          tot[nb][mb][0] += __uint_as_float(sg[nb][mb][0] << 16) * ac[nb][mb][0];
          tot[nb][mb][1] += __uint_as_float(sg[nb][mb][0] & 0xffff0000u) * ac[nb][mb][1];
          tot[nb][mb][2] += __uint_as_float(sg[nb][mb][1] << 16) * ac[nb][mb][2];
          tot[nb][mb][3] += __uint_as_float(sg[nb][mb][1] & 0xffff0000u) * ac[nb][mb][3];
        }
    }
    u16* dst = p.MERGED + (size_t)m0 * DM + n0;
    epilogue_bf16<2>(tot, smem, dst, DM, [&](int, int, f32x4 v) { return v; });
    mt = mt2; nt = nt2; have = have2;
  }
}

__device__ void phase_resid(const Params& p, const u16* A, int K, const u16* W, int ldw, char* smem, int dry) {
  for (int k = 0;; ++k) {
    int mt, nt;
    if (!next_tile(k, 128, 4, mt, nt)) break;
    f32x4 acc[8][4];
    zero_acc<4>(acc);
    gemm_core<4>(acc, A + (size_t)mt * 256 * K, K, W + (size_t)nt * 256 * ldw, ldw, K, smem);
    float* dst = p.out + (size_t)mt * 256 * DM + nt * 256;
    epilogue<4>(acc, smem, [&](int row, int col, f32x4 v) {
      f32x4* px = (f32x4*)(dst + (size_t)row * DM + col);
      f32x4 x = *px;
      x[0] += v[0]; x[1] += v[1]; x[2] += v[2]; x[3] += v[3];
      if (!dry) *px = x;
    });
  }
}

__device__ void phase_G4(const Params& p, char* smem) {
  u32x4 ra[4], rw[4];
  bool pre = false;
  int mt, nt;
  bool have = next_tile(0, 128, 22, mt, nt);
  for (int k = 0; have; ++k) {
    int mt2 = 0, nt2 = 0;
    const bool have2 = next_tile(k + 1, 128, 22, mt2, nt2);
    f32x4 acc[8][4];
    zero_acc<4>(acc);
    gemm_core<4>(acc, p.XN + (size_t)mt * 256 * XLD, XLD, p.WguT + (size_t)nt * 256 * XLD, XLD, DM, smem, ra, rw, pre,
                 have2 ? p.XN + (size_t)mt2 * 256 * XLD : nullptr, XLD, p.WguT + (size_t)nt2 * 256 * XLD, XLD);
    pre = have2;
    f32x4 hv[4][4];
#pragma unroll
    for (int pb = 0; pb < 4; ++pb) {
      const int nbg = (pb >> 1) * 4 + (pb & 1);
#pragma unroll
      for (int mb = 0; mb < 4; ++mb)
#pragma unroll
        for (int j = 0; j < 4; ++j) hv[pb][mb][j] = siluf_(acc[nbg][mb][j]) * acc[nbg + 2][mb][j];
    }
    u16* dst = p.H + (size_t)mt * 256 * FH + nt * 128;
    epilogue_bf16<2>(hv, smem, dst, FH, [&](int, int, f32x4 v) { return v; });
    mt = mt2; nt = nt2; have = have2;
  }
}

__device__ void phase_final(const Params& p) { rmsnorm_rows(p.out, p.norm_final, nullptr, p.out); }

DI void grid_barrier(unsigned* bar, unsigned target) {
  __syncthreads();
  if (TIDX == 0) {
    __threadfence();
    __hip_atomic_fetch_add(bar, 1u, __ATOMIC_RELAXED, __HIP_MEMORY_SCOPE_AGENT);
    while (__hip_atomic_load(bar, __ATOMIC_RELAXED, __HIP_MEMORY_SCOPE_AGENT) < target) __builtin_amdgcn_s_sleep(4);
    __threadfence();
  }
  __syncthreads();
}

#define XB_TMO      128
#define XB_XCNT(j)  (256  + 64 * (j))
#define XB_XSUB(j)  (1280 + 64 * (j))
#define XB_XGEN(j)  (2304 + 64 * (j))
#define XB_TOP      3328
#define XB_TOPGEN   3392
#define XCD_BAR_WORDS 3456
#define XB_SPIN_CAP (1u << 20)
#define LAS __attribute__((address_space(3)))
DI unsigned xb_ld(unsigned* p) { return __hip_atomic_load(p, __ATOMIC_RELAXED, __HIP_MEMORY_SCOPE_AGENT); }
DI unsigned xb_add(unsigned* p, unsigned v) { return __hip_atomic_fetch_add(p, v, __ATOMIC_RELAXED, __HIP_MEMORY_SCOPE_AGENT); }
DI unsigned xb_xcc_id() { return (unsigned)__builtin_amdgcn_s_getreg((3 << 11) | 20) & 0xFu; }
#define XB_SPIN(cond, bar) do { unsigned _sp = 0; while (cond) { __builtin_amdgcn_s_sleep(1); \
    if ((++_sp & 255u) == 0u) { if (xb_ld(&(bar)[XB_TMO])) break; if (_sp > XB_SPIN_CAP) { atomicAdd(&(bar)[XB_TMO], 1u); break; } } } } while (0)
DI void xcd_barrier_post(unsigned* bar) {
  if (threadIdx.x == 0) (void)xb_add(&bar[XB_XCNT(xb_xcc_id())], 1u);
}
DI void xcd_barrier_complete(unsigned* bar, unsigned x, unsigned& nloc, unsigned& nx) {
  const unsigned G = gridDim.x;
  unsigned sum, cnt, mine, sp = 0u;
  for (;;) {
    sum = 0u; cnt = 0u; mine = 0u;
#pragma unroll
    for (unsigned j = 0; j < 16; ++j) { const unsigned c = xb_ld(&bar[XB_XCNT(j)]); sum += c; cnt += (c > 0u) ? 1u : 0u; mine = (j == x) ? c : mine; }
    if (sum == G) break;
    __builtin_amdgcn_s_sleep(1);
    if ((++sp & 255u) == 0u) { if (xb_ld(&bar[XB_TMO])) break; if (sp > XB_SPIN_CAP) { atomicAdd(&bar[XB_TMO], 1u); break; } }
  }
  nloc = mine > 0u ? mine : 1u; nx = cnt > 0u ? cnt : 1u;
}
DI void xcd_barrier(unsigned* bar, volatile LAS unsigned* st) {
  asm volatile("s_waitcnt vmcnt(0)" ::: "memory");
  __syncthreads();
  if (threadIdx.x == 0) {
    __builtin_amdgcn_s_waitcnt(0);
    const unsigned x = xb_xcc_id();
    unsigned nloc = st[0], nx = st[1];
    if (nloc == 0u) { xcd_barrier_complete(bar, x, nloc, nx); st[0] = nloc; st[1] = nx; }
    const unsigned old = xb_add(&bar[XB_XSUB(x)], 1u);
    const unsigned gen = old / nloc;
    if (old + 1u == (gen + 1u) * nloc) {
      __builtin_amdgcn_fence(__ATOMIC_RELEASE, "agent");
      asm volatile("s_waitcnt vmcnt(0)" ::: "memory");
      const unsigned og = xb_add(&bar[XB_TOP], 1u);
      const unsigned tg = og / nx;
      if (og + 1u == (tg + 1u) * nx) xb_add(&bar[XB_TOPGEN], 1u);
      else XB_SPIN(xb_ld(&bar[XB_TOPGEN]) == tg, bar);
      __builtin_amdgcn_fence(__ATOMIC_ACQUIRE, "agent");
      xb_add(&bar[XB_XGEN(x)], 1u);
      asm volatile("s_waitcnt vmcnt(0)" ::: "memory");
    } else {
      XB_SPIN(xb_ld(&bar[XB_XGEN(x)]) == gen, bar);
      __builtin_amdgcn_fence(__ATOMIC_ACQUIRE, "agent");
      asm volatile("s_waitcnt vmcnt(0)" ::: "memory");
    }
  }
  __syncthreads();
}

constexpr int NPH = 12;
DI void run_phase(const Params& p, int l, int ph, char* smem, int dry = 0) {
  asm volatile("" : "+s"(l));
  switch (ph) {
    case 0: phase_A(p, l, smem); break;
    case 1: phase_G1(p, smem); break;
    case 2: phase_pre(p, l); break;
    case 3: phase_prep(p, l, smem); break;
    case 4: phase_mix(p, l, smem, dry); break;
    case 11: phase_attn(p, l, smem, dry); break;
    case 5: phase_post(p, l, smem); break;
    case 6: phase_G2(p, l, smem); break;
    case 7: phase_resid(p, p.MERGED, DM, p.WoutT, XLD, smem, dry); break;
    case 8: rmsnorm_rows(p.out, p.norm_ffn + l * DM, p.XN, nullptr); break;
    case 9: phase_G4(p, smem); break;
    case 10: phase_resid(p, p.H, FH, p.WdownT, FH, smem, dry); break;
    default: break;
  }
}

#if MULTI
template <int PH>
__global__ void __launch_bounds__(NTHR) k_phase(Params p, int l) {
  __shared__ __attribute__((aligned(16))) char smem[SMEM_BYTES];
  if (PH < NPH) run_phase(p, l, PH, smem);
  else phase_final(p);
}
#else
__global__ void __launch_bounds__(NTHR) k_mega(Params p) {
  __shared__ __attribute__((aligned(16))) char smem[SMEM_BYTES];
  cg::grid_group grid = cg::this_grid();
  __shared__ uint4 xb_words;
  if (threadIdx.x == 0) xb_words = make_uint4(0u, 0u, 0u, 0u);
  __syncthreads();
  unsigned* bar = (unsigned*)p.ctr;
  if (blockIdx.x == 0) for (int i = threadIdx.x; i < XCD_BAR_WORDS; i += NTHR) bar[i] = 0u;
  for (int l = 0; l < 2; ++l) {
#pragma unroll 1
    for (int i = 0; i < NPH; ++i) {
      const int ph = i < 4 ? i : (i == 4 ? 11 : i - 1);
      run_phase(p, l, ph, smem);
      if (l == 0 && i == 0) { grid.sync(); xcd_barrier_post(bar); }
      else xcd_barrier(bar, (volatile LAS unsigned*)&xb_words);
    }
  }
  phase_final(p);
}
#endif

extern "C" void kernel_launch(void* const* d_in, const int* in_sizes, int n_in, void* d_out, int out_size, void* d_ws, size_t ws_size,
                              hipStream_t stream) {
  Params p{};
  const float** pf = (const float**)&p;
  for (int i = 0; i < 34; ++i) pf[i] = (const float*)d_in[i];
  p.out = (float*)d_out;
  char* ws = (char*)d_ws;
  size_t off = 0;
  auto take = [&](size_t bytes) { char* r = ws + off; off += (bytes + 255) & ~(size_t)255; return r; };
  p.ctr = (int*)take(16384);
  p.WinT = (u16*)take((size_t)PLD * XLD * 2);
  p.WgT = (u16*)take((size_t)3072 * XLD * 2);
  p.WbrT = (u16*)take((size_t)3 * 1024 * 512 * 2);
  p.WoutT = (u16*)take((size_t)1024 * XLD * 2);
  p.w2T = (u16*)take(512 * 64 * 2);
  p.a2T = (u16*)take(512 * 64 * 2);
  p.g2T = (u16*)take(512 * 192 * 2);
  p.v2T = (u16*)take(512 * 64 * 2);
  char* shared = take((size_t)M_TOK * LALD * 2);
  p.LA = (u16*)shared;
  p.WguT = (u16*)shared;
  p.WdownT = (u16*)(shared + (size_t)2 * FH * XLD * 2);
  p.XN = (u16*)take((size_t)M_TOK * XLD * 2);
  p.PROJ = (u16*)take((size_t)M_TOK * PLD * 2);
  p.H = p.PROJ;
  p.VF = (u16*)take((size_t)M_TOK * 512 * 2);
  p.AA = (u16*)take((size_t)M_TOK * 512 * 2);
  p.WR = (u16*)take((size_t)M_TOK * 512 * 2);
  p.GG = (u16*)take((size_t)M_TOK * 512 * 2);
  p.MERGED = p.AA;
  if (off > ws_size || n_in != 34) { fprintf(stderr, "kernel_launch: workspace too small (%zu needed, %zu given) or n_in %d\n", off, ws_size, n_in); return; }
#if MULTI
#define LP(PH) hipLaunchKernelGGL(k_phase<PH>, dim3(256), dim3(NTHR), 0, stream, p, l)
  for (int l = 0; l < 2; ++l) { LP(0); LP(1); LP(2); LP(3); LP(11); LP(4); LP(5); LP(6); LP(7); LP(8); LP(9); LP(10); }
  { int l = 0; LP(12); }
#else
  static int grid = 0;
  if (!grid) {
    int dev = 0, cus = 0, per_cu = 0;
    hipGetDevice(&dev);
    hipDeviceGetAttribute(&cus, hipDeviceAttributeMultiprocessorCount, dev);
    (void)hipOccupancyMaxActiveBlocksPerMultiprocessor(&per_cu, k_mega, NTHR, 0);
    if (per_cu < 1) per_cu = 1;
    if (per_cu > 1) per_cu = 1;
    grid = cus * per_cu;
  }
  void* args[] = {&p};
  hipError_t e = hipLaunchCooperativeKernel((void*)k_mega, dim3(grid), dim3(NTHR), args, 0, stream);
  if (e != hipSuccess) fprintf(stderr, "cooperative launch failed: %s (grid %d)\n", hipGetErrorString(e), grid);
#endif
}
```

```cpp
#include <hip/hip_runtime.h>
#include <hip/hip_cooperative_groups.h>
#include <cstdio>
#include <cstdint>
namespace cg = cooperative_groups;

#ifndef MULTI
#define MULTI 0
#endif

typedef unsigned short u16;
typedef short bf16x8 __attribute__((ext_vector_type(8)));
typedef short s16x4 __attribute__((ext_vector_type(4)));
typedef float f32x16 __attribute__((ext_vector_type(16)));
typedef float f32x4 __attribute__((ext_vector_type(4)));
typedef float f32x2 __attribute__((ext_vector_type(2)));
typedef unsigned u32x4 __attribute__((ext_vector_type(4)));

#define DI __device__ __forceinline__
#define MFMA(a, b, c) __builtin_amdgcn_mfma_f32_32x32x16_bf16((a), (b), (c), 0, 0, 0)
#define MFMA16(a, b, c) __builtin_amdgcn_mfma_f32_16x16x32_bf16((a), (b), (c), 0, 0, 0)

constexpr int M_TOK = 32768;
constexpr int SEQ = 2048;
constexpr int DM = 1024;
constexpr int PLD = 4224;
constexpr int C_R = 0, C_K = 512, C_V = 1024, C_LW = 1536, C_LA = 1600, C_LG = 1664;
constexpr int C_LV = 1824, C_Z = 1856, C_XBC = 2368, C_DT = 3392, C_Q = 3456, C_AK = 3968, C_AV = 4096;
constexpr int LALD = 384;
constexpr int XLD = 1088;
constexpr int FH = 2816;
constexpr int SMEM_BYTES = 147456;
constexpr int NTHR = 512;
constexpr int NWV = 8;

struct Params {
  const float* x; const float* norm_mix; const float* w_in; const float* rw_mu; const float* rw_w0; const float* rw_w2;
  const float* rw_a0; const float* rw_a2; const float* rw_g2; const float* rw_k_k; const float* rw_k_a; const float* rw_r_k;
  const float* rw_gn_w; const float* rw_gn_b; const float* vres_down; const float* vres_mu; const float* vres_v0; const float* vres_v2;
  const float* conv_w; const float* conv_b; const float* dt_bias; const float* a_log; const float* ssm_d; const float* ssm_norm_w;
  const float* sinks; const float* gate_b; const float* w_br_rw; const float* w_br_ssm; const float* w_br_att; const float* w_out;
  const float* norm_ffn; const float* w_gu; const float* w_down; const float* norm_final;
  float* out;
  u16 *WinT, *WgT, *WbrT, *WoutT, *w2T, *a2T, *g2T, *v2T, *WguT, *WdownT, *LA, *XN, *PROJ, *VF, *AA, *WR, *GG, *MERGED, *H;
  int* ctr;
};

DI int tidx_() { int t = (int)__builtin_amdgcn_workitem_id_x(); asm volatile("" : "+v"(t)); return t; }
DI int bidx_() { int t = (int)__builtin_amdgcn_workgroup_id_x(); asm volatile("" : "+s"(t)); return t; }
DI int gdim_() { int t = (int)gridDim.x; asm volatile("" : "+s"(t)); return t; }
#define TIDX tidx_()
#define BIDX bidx_()
#define GDIM gdim_()

DI float bf2f(u16 v) { return __uint_as_float(((unsigned)v) << 16); }
DI u16 f2bf(float f) { unsigned u = __float_as_uint(f); u += 0x7fffu + ((u >> 16) & 1u); return (u16)(u >> 16); }
DI unsigned pack2(float a, float b) { return (unsigned)f2bf(a) | ((unsigned)f2bf(b) << 16); }
DI unsigned cvt_pk_bf16(float a, float b) { unsigned r; asm volatile("s_nop 4\n\tv_cvt_pk_bf16_f32 %0, %1, %2\n\ts_nop 1" : "=v"(r) : "v"(a), "v"(b)); return r; }
DI float sigmoidf_(float x) { return __builtin_amdgcn_rcpf(1.f + __expf(-x)); }
DI float siluf_(float x) { return x * sigmoidf_(x); }
DI float tanhf_(float x) { return 1.f - 2.f * __builtin_amdgcn_rcpf(1.f + __expf(2.f * x)); }
DI float softplusf_(float z) { return z > 20.f ? z : __logf(1.f + __expf(z)); }
DI int crow(int r, int h) { return (r & 3) + 8 * (r >> 2) + 4 * h; }
DI float dppf(float x, const int ctrl_sel) {
  int xi = __float_as_int(x);
  int r;
  if (ctrl_sel == 0) r = __builtin_amdgcn_update_dpp(0, xi, 0xB1, 0xF, 0xF, true);
  else if (ctrl_sel == 1) r = __builtin_amdgcn_update_dpp(0, xi, 0x4E, 0xF, 0xF, true);
  else r = __builtin_amdgcn_update_dpp(0, xi, 0x141, 0xF, 0xF, true);
  return __int_as_float(r);
}
DI float red8(float x) {
  x += dppf(x, 0);
  x += dppf(x, 1);
  x += dppf(x, 2);
  return x;
}
DI float red16(float x) {
  x = red8(x);
  x += __int_as_float(__builtin_amdgcn_update_dpp(0, __float_as_int(x), 0x140, 0xF, 0xF, true));
  return x;
}
DI float wave_sum(float v) {
  v = red8(v);
  v += __int_as_float(__builtin_amdgcn_update_dpp(0, __float_as_int(v), 0x140, 0xF, 0xF, true));
  const float r0 = __int_as_float(__builtin_amdgcn_readlane(__float_as_int(v), 0));
  const float r1 = __int_as_float(__builtin_amdgcn_readlane(__float_as_int(v), 16));
  const float r2 = __int_as_float(__builtin_amdgcn_readlane(__float_as_int(v), 32));
  const float r3 = __int_as_float(__builtin_amdgcn_readlane(__float_as_int(v), 48));
  return (r0 + r1) + (r2 + r3);
}

__device__ void cvt_T(const float* __restrict__ src, int K, int ld, int c0, int ncols, u16* __restrict__ dst, int dld, int r0,
                      int mode, char* smem) {
  float* tl = (float*)smem;
  const int ct = (ncols + 31) >> 5, kt = (K + 63) >> 6;
  const int tid = TIDX;
  const int nt = ct * kt, gd = GDIM;
  const int rk = tid >> 5, rc = tid & 31;
  float v[4];
  auto LOADT = [&](int t) {
    const int cb = (t % ct) * 32, kb = (t / ct) * 64;
#pragma unroll
    for (int i = 0; i < 4; ++i) {
      const int k = rk + 16 * i;
      v[i] = 0.f;
      if (cb + rc < ncols && kb + k < K) v[i] = src[(size_t)(kb + k) * ld + c0 + cb + rc];
    }
  };
  int t = BIDX;
  if (t < nt) LOADT(t);
  for (; t < nt; t += gd) {
    const int cb = (t % ct) * 32, kb = (t / ct) * 64;
    __syncthreads();
#pragma unroll
    for (int i = 0; i < 4; ++i) tl[rc * 65 + rk + 16 * i] = v[i];
    __syncthreads();
    if (t + gd < nt) LOADT(t + gd);
    {
      const int c = tid >> 4, kc = tid & 15;
      if (cb + c < ncols) {
        int drow;
        if (mode == 0) drow = r0 + cb + c;
        else { const int ty = cb >= FH ? 1 : 0; const int j0 = cb - ty * FH; drow = (j0 >> 5) * 64 + ty * 32 + c; }
        const float* sp = tl + c * 65 + kc * 4;
        uint2 o; o.x = pack2(sp[0], sp[1]); o.y = pack2(sp[2], sp[3]);
        *(uint2*)(dst + (size_t)drow * dld + kb + kc * 4) = o;
      }
    }
  }
  __syncthreads();
}

template <int NI>
DI void gemm_core(f32x4 (&acc)[2 * NI][4], const u16* __restrict__ A, int lda, const u16* __restrict__ W, int ldw, int K, char* smem,
                  u32x4 (&ra)[4], u32x4 (&rw)[NI], bool pre, const u16* nA, int nlda, const u16* nW, int nldw) {
  constexpr int A_ELEMS = 256 * 64;
  constexpr int W_ELEMS = 64 * NI * 64;
  u16* As = (u16*)smem;
  u16* Ws = As + 2 * A_ELEMS;
  const int tid = TIDX, lane = tid & 63, wave = tid >> 6;
  const int wm = wave >> 1, wn = wave & 1, fr = lane & 15, fq = lane >> 4;
  const int lr = tid >> 3, lc = tid & 7;
  unsigned opq = 0;
  asm volatile("" : "+v"(opq));
  const u16* ag = A + (size_t)lr * lda + lc * 8 + opq;
  const u16* wg = W + (size_t)lr * ldw + lc * 8 + opq;
  const int sw_st = (lc ^ ((lr >> 1) & 7)) * 8;
  auto GLOAD = [&](int k0) {
#pragma unroll
    for (int i = 0; i < 4; ++i) ra[i] = *(const u32x4*)(ag + (size_t)(64 * i) * lda + k0);
#pragma unroll
    for (int i = 0; i < NI; ++i) rw[i] = *(const u32x4*)(wg + (size_t)(64 * i) * ldw + k0);
  };
  auto GLOADNEXT = [&]() {
    const u16* ag2 = nA + (size_t)lr * nlda + lc * 8 + opq;
    const u16* wg2 = nW + (size_t)lr * nldw + lc * 8 + opq;
#pragma unroll
    for (int i = 0; i < 4; ++i) ra[i] = *(const u32x4*)(ag2 + (size_t)(64 * i) * nlda);
#pragma unroll
    for (int i = 0; i < NI; ++i) rw[i] = *(const u32x4*)(wg2 + (size_t)(64 * i) * nldw);
  };
  auto SSTORE = [&](int buf) {
#pragma unroll
    for (int i = 0; i < 4; ++i) *(u32x4*)(As + buf * A_ELEMS + (lr + 64 * i) * 64 + sw_st) = ra[i];
#pragma unroll
    for (int i = 0; i < NI; ++i) *(u32x4*)(Ws + buf * W_ELEMS + (lr + 64 * i) * 64 + sw_st) = rw[i];
  };
  const int swz = fr >> 1;
  const int off0 = ((0 + fq) ^ swz) * 8, off1 = ((4 + fq) ^ swz) * 8;
  const int KT = K >> 6;
  if (!pre) GLOAD(0);
  SSTORE(0);
  if (KT > 1) GLOAD(64);
  else if (nA) GLOADNEXT();
  __syncthreads();
#pragma unroll 1
  for (int kt = 0; kt < KT; ++kt) {
    const int buf = kt & 1;
    if (kt + 1 < KT) {
      SSTORE(buf ^ 1);
      if (kt + 2 < KT) GLOAD((kt + 2) * 64);
      else if (nA) GLOADNEXT();
    }
    const u16* as = As + buf * A_ELEMS + (wm * 64 + fr) * 64;
    const u16* ws = Ws + buf * W_ELEMS + (wn * 32 * NI + fr) * 64;
#pragma unroll
    for (int ks = 0; ks < 2; ++ks) {
      const int off = ks ? off1 : off0;
      bf16x8 wf[2 * NI], af[4];
#pragma unroll
      for (int nb = 0; nb < 2 * NI; ++nb) wf[nb] = *(const bf16x8*)(ws + nb * 16 * 64 + off);
#pragma unroll
      for (int mb = 0; mb < 4; ++mb) af[mb] = *(const bf16x8*)(as + mb * 16 * 64 + off);
#pragma unroll
      for (int nb = 0; nb < 2 * NI; ++nb)
#pragma unroll
        for (int mb = 0; mb < 4; ++mb) acc[nb][mb] = MFMA16(wf[nb], af[mb], acc[nb][mb]);
    }
    __syncthreads();
  }
}
template <int NI>
DI void gemm_core(f32x4 (&acc)[2 * NI][4], const u16* __restrict__ A, int lda, const u16* __restrict__ W, int ldw, int K, char* smem) {
  u32x4 ra[4], rw[NI];
  gemm_core<NI>(acc, A, lda, W, ldw, K, smem, ra, rw, false, nullptr, 0, nullptr, 0);
}

template <int NI>
DI void zero_acc(f32x4 (&acc)[2 * NI][4]) {
#pragma unroll
  for (int nb = 0; nb < 2 * NI; ++nb)
#pragma unroll
    for (int mb = 0; mb < 4; ++mb) acc[nb][mb] = f32x4{0.f, 0.f, 0.f, 0.f};
}

template <int NI, typename F>
DI void epilogue(f32x4 (&acc)[2 * NI][4], char* smem, F epi) {
  constexpr int SLD = 132;
  float* st = (float*)smem;
  const int tid = TIDX, lane = tid & 63, wave = tid >> 6;
  const int wm = wave >> 1, wn = wave & 1, fr = lane & 15, fq = lane >> 4;
#pragma unroll
  for (int q = 0; q < NI / 2; ++q) {
#pragma unroll
    for (int nn = 0; nn < 4; ++nn)
#pragma unroll
      for (int mb = 0; mb < 4; ++mb)
        *(f32x4*)(st + (wm * 64 + mb * 16 + fr) * SLD + wn * 64 + nn * 16 + fq * 4) = acc[4 * q + nn][mb];
    __syncthreads();
    for (int idx = tid; idx < 256 * 32; idx += NTHR) {
      const int row = idx >> 5, sc = (idx & 31) * 4;
      f32x4 v = *(const f32x4*)(st + row * SLD + sc);
      epi(row, (sc >> 6) * (32 * NI) + q * 64 + (sc & 63), v);
    }
    __syncthreads();
  }
}

DI bool next_tile(int k, int MT, int NT, int& mt, int& nt) {
  const int bid = BIDX, gd = GDIM;
  int tl = (gd == 256) ? k * 256 + (bid & 7) * 32 + (bid >> 3) : k * gd + bid;
  if (tl >= MT * NT) return false;
  const int band = tl / (MT * 8);
  const int w = (NT - band * 8) < 8 ? (NT - band * 8) : 8;
  const int within = tl - band * MT * 8;
  mt = within / w;
  nt = band * 8 + within % w;
  return true;
}

DI void lds_barrier() { asm volatile("s_waitcnt lgkmcnt(0)\n\ts_barrier" ::: "memory"); }

template <int NI, typename F>
DI void epilogue_bf16(f32x4 (&acc)[2 * NI][4], char* smem, u16* dst, int ld, F tr) {
  constexpr int SLD = 264;
  u16* st = (u16*)smem;
  const int tid = TIDX, lane = tid & 63, wave = tid >> 6;
  const int wm = wave >> 1, wn = wave & 1, fr = lane & 15, fq = lane >> 4;
#pragma unroll
  for (int nb = 0; nb < 2 * NI; ++nb)
#pragma unroll
    for (int mb = 0; mb < 4; ++mb) {
      const int row = wm * 64 + mb * 16 + fr, col = wn * 32 * NI + nb * 16 + fq * 4;
      const f32x4 v = tr(row, col, acc[nb][mb]);
      uint2 o; o.x = pack2(v[0], v[1]); o.y = pack2(v[2], v[3]);
      *(uint2*)(st + row * SLD + col) = o;
    }
  lds_barrier();
  constexpr int CH = 8 * NI;
  for (int idx = tid; idx < 256 * CH; idx += NTHR) {
    const int row = idx / CH, ch = idx % CH;
    const u32x4 v = *(const u32x4*)(st + row * SLD + ch * 8);
    *(u32x4*)(dst + (size_t)row * ld + ch * 8) = v;
  }
  lds_barrier();
}

DI void store_bf4(u16* dst, f32x4 v) {
  uint2 o; o.x = pack2(v[0], v[1]); o.y = pack2(v[2], v[3]);
  *(uint2*)dst = o;
}

__device__ void rmsnorm_rows(const float* xin, const float* __restrict__ w, u16* xn, float* copy_to) {
  const int lane = TIDX & 63;
  const int gw = BIDX * NWV + (TIDX >> 6), nw = GDIM * NWV;
  for (int row = gw; row < M_TOK; row += nw) {
    const float* xr = xin + (size_t)row * DM;
    f32x4 v[4];
    float ss = 0.f;
#pragma unroll
    for (int i = 0; i < 4; ++i) {
      v[i] = *(const f32x4*)(xr + i * 256 + lane * 4);
      ss += v[i][0] * v[i][0] + v[i][1] * v[i][1] + v[i][2] * v[i][2] + v[i][3] * v[i][3];
    }
    ss = wave_sum(ss);
    const float rstd = rsqrtf(ss * (1.f / DM) + 1e-6f);
#pragma unroll
    for (int i = 0; i < 4; ++i) {
      const f32x4 ww = *(const f32x4*)(w + i * 256 + lane * 4);
      f32x4 o = {v[i][0] * rstd * ww[0], v[i][1] * rstd * ww[1], v[i][2] * rstd * ww[2], v[i][3] * rstd * ww[3]};
      if (xn) store_bf4(xn + (size_t)row * XLD + i * 256 + lane * 4, o);
      else *(f32x4*)(copy_to + (size_t)row * DM + i * 256 + lane * 4) = o;
      if (xn && copy_to) *(f32x4*)(copy_to + (size_t)row * DM + i * 256 + lane * 4) = v[i];
    }
  }
}

__device__ void phase_A(const Params& p, int l, char* smem) {
  const float* win = p.w_in + (size_t)l * DM * 7208;
  cvt_T(win, 1024, 7208, 0, 1824, p.WinT, XLD, 0, 0, smem);
  cvt_T(win, 1024, 7208, 1824, 1544, p.WinT, XLD, C_Z, 0, smem);
  cvt_T(win, 1024, 7208, 3368, 768, p.WinT, XLD, C_Q, 0, smem);
  if (l == 1) cvt_T(p.vres_down, 1024, 32, 0, 32, p.WinT, XLD, C_LV, 0, smem);
  cvt_T(win, 1024, 7208, 4136, 3072, p.WgT, XLD, 0, 0, smem);
  cvt_T(p.w_br_rw + (size_t)l * 512 * 1024, 512, 1024, 0, 1024, p.WbrT, 512, 0, 0, smem);
  cvt_T(p.w_br_ssm + (size_t)l * 512 * 1024, 512, 1024, 0, 1024, p.WbrT + 1024 * 512, 512, 0, 0, smem);
  cvt_T(p.w_br_att + (size_t)l * 512 * 1024, 512, 1024, 0, 1024, p.WbrT + 2 * 1024 * 512, 512, 0, 0, smem);
  cvt_T(p.w_out + (size_t)l * 1024 * 1024, 1024, 1024, 0, 1024, p.WoutT, XLD, 0, 0, smem);
  cvt_T(p.rw_w2 + (size_t)l * 64 * 512, 64, 512, 0, 512, p.w2T, 64, 0, 0, smem);
  cvt_T(p.rw_a2 + (size_t)l * 64 * 512, 64, 512, 0, 512, p.a2T, 64, 0, 0, smem);
  cvt_T(p.rw_g2 + (size_t)l * 160 * 512, 160, 512, 0, 512, p.g2T, 192, 0, 0, smem);
  if (l == 1) cvt_T(p.vres_v2, 32, 512, 0, 512, p.v2T, 64, 0, 0, smem);
  if (l == 0) rmsnorm_rows(p.x, p.norm_mix, p.XN, p.out);
  else rmsnorm_rows(p.out, p.norm_mix + DM, p.XN, nullptr);
}

__device__ void phase_G1(const Params& p, char* smem) {
  u32x4 ra[4], rw[4];
  bool pre = false;
  int mt, j;
  bool have = next_tile(0, 128, 17, mt, j);
  for (int k = 0; have; ++k) {
    int mt2 = 0, j2 = 0;
    const bool have2 = next_tile(k + 1, 128, 17, mt2, j2);
    const u16* A = p.XN + (size_t)mt * 256 * XLD;
    u16* dst = p.PROJ + (size_t)mt * 256 * PLD + j * 256;
    if (j < 16) {
      const bool nx = have2 && j2 < 16;
      f32x4 acc[8][4];
      zero_acc<4>(acc);
      gemm_core<4>(acc, A, XLD, p.WinT + (size_t)j * 256 * XLD, XLD, DM, smem, ra, rw, pre,
                   nx ? p.XN + (size_t)mt2 * 256 * XLD : nullptr, XLD, p.WinT + (size_t)j2 * 256 * XLD, XLD);
      pre = nx;
      epilogue_bf16<4>(acc, smem, dst, PLD, [&](int, int, f32x4 v) { return v; });
    } else {
      f32x4 acc[4][4];
      zero_acc<2>(acc);
      gemm_core<2>(acc, A, XLD, p.WinT + (size_t)j * 256 * XLD, XLD, DM, smem);
      pre = false;
      epilogue_bf16<2>(acc, smem, dst, PLD, [&](int, int, f32x4 v) { return v; });
    }
    mt = mt2; j = j2; have = have2;
  }
}

__device__ void phase_pre(const Params& p, int l) {
  const int lane = TIDX & 63;
  const int gw = BIDX * NWV + (TIDX >> 6), nw = GDIM * NWV;
  const float* mu = p.rw_mu + l * 1824;
  for (int row = gw; row < M_TOK; row += nw) {
    const bool hp = (row & (SEQ - 1)) != 0;
    const u16* pr = p.PROJ + (size_t)row * PLD;
    const u16* pp = pr - PLD;
    u16* la = p.LA + (size_t)row * LALD;
    auto mix = [&](int colp, float m) {
      const float a = bf2f(pr[colp]);
      const float b = hp ? bf2f(pp[colp]) : 0.f;
      return a + (b - a) * m;
    };
    la[lane] = f2bf(tanhf_(mix(C_LW + lane, mu[C_LW + lane])));
    la[64 + lane] = f2bf(mix(C_LA + lane, mu[C_LA + lane]));
    la[128 + lane] = f2bf(sigmoidf_(mix(C_LG + lane, mu[C_LG + lane])));
    la[192 + lane] = f2bf(sigmoidf_(mix(C_LG + 64 + lane, mu[C_LG + 64 + lane])));
    u16 e4 = 0;
    if (lane < 32) e4 = f2bf(sigmoidf_(mix(C_LG + 128 + lane, mu[C_LG + 128 + lane])));
    la[256 + lane] = e4;
    u16 e5 = 0;
    if (l == 1 && lane < 32) e5 = f2bf(mix(C_LV + lane, p.vres_mu[lane]));
    la[320 + lane] = e5;
    if (l == 0) {
#pragma unroll
      for (int j = 0; j < 8; ++j) {
        const int c = lane + 64 * j;
        p.VF[(size_t)row * 512 + c] = f2bf(mix(C_V + c, mu[C_V + c]));
      }
    }
  }
}

__device__ void phase_prep(const Params& p, int l, char* smem) {
  const int nk = (l == 1) ? 4 : 3;
  for (int k = 0;; ++k) {
    int mt, kn;
    if (!next_tile(k, 128, 2 * nk, mt, kn)) break;
    const int kind = kn >> 1, nt = kn & 1;
    const int koff = kind == 0 ? 0 : (kind == 1 ? 64 : (kind == 2 ? 128 : 320));
    const int Kk = kind == 2 ? 192 : 64;
    const u16* Wk = kind == 0 ? p.w2T : (kind == 1 ? p.a2T : (kind == 2 ? p.g2T : p.v2T));
    f32x4 acc[8][4];
    zero_acc<4>(acc);
    gemm_core<4>(acc, p.LA + (size_t)mt * 256 * LALD + koff, LALD, Wk + (size_t)nt * 256 * Kk, Kk, Kk, smem);
    const int m0 = mt * 256, n0 = nt * 256;
    if (kind == 0) {
      const float* w0 = p.rw_w0 + l * 512 + n0;
      epilogue_bf16<4>(acc, smem, p.WR + (size_t)m0 * 512 + n0, 512, [&](int, int col, f32x4 v) {
        const f32x4 b = *(const f32x4*)(w0 + col);
        f32x4 o = {v[0] + b[0], v[1] + b[1], v[2] + b[2], v[3] + b[3]};
        return o;
      });
    } else if (kind == 1) {
      const float* a0 = p.rw_a0 + l * 512 + n0;
      epilogue_bf16<4>(acc, smem, p.AA + (size_t)m0 * 512 + n0, 512, [&](int, int col, f32x4 v) {
        const f32x4 b = *(const f32x4*)(a0 + col);
        f32x4 o = {sigmoidf_(v[0] + b[0]), sigmoidf_(v[1] + b[1]), sigmoidf_(v[2] + b[2]), sigmoidf_(v[3] + b[3])};
        return o;
      });
    } else if (kind == 2) {
      epilogue_bf16<4>(acc, smem, p.GG + (size_t)m0 * 512 + n0, 512, [&](int, int, f32x4 v) { return v; });
    } else {
      const float* v0 = p.vres_v0 + n0;
      const float* mu = p.rw_mu + l * 1824 + C_V + n0;
      epilogue<4>(acc, smem, [&](int row, int col, f32x4 v) {
        const int m = m0 + row;
        const bool hp = (m & (SEQ - 1)) != 0;
        const u16* pr = p.PROJ + (size_t)m * PLD + C_V + n0 + col;
        u16* vf = p.VF + (size_t)m * 512 + n0 + col;
        f32x4 o;
#pragma unroll
        for (int j = 0; j < 4; ++j) {
          const float a = bf2f(pr[j]);
          const float b = hp ? bf2f(pr[j - PLD]) : 0.f;
          const float vv = a + (b - a) * mu[col + j];
          const float gate = sigmoidf_(v0[col + j] + v[j]);
          const float f = bf2f(vf[j]);
          o[j] = vv + (f - vv) * gate;
        }
        store_bf4(vf, o);
      });
    }
  }
}

__device__ void rwkv_item(const Params& p, int l, int item, char* smem, int dry) {
  const int b = item >> 3, hh = item & 7;
  const int tid = TIDX, lane = tid & 63, wave = tid >> 6;
  float* stg = (float*)smem;
  float* ybuf = stg + 2 * 16 * 448;
  float* bon = ybuf + 16 * 64;
  const int col = hh * 64 + lane;
  const float mu_r = p.rw_mu[l * 1824 + C_R + col], mu_k = p.rw_mu[l * 1824 + C_K + col];
  const float kk_w = p.rw_k_k[l * 512 + col], ka_w = p.rw_k_a[l * 512 + col], rk_w = p.rw_r_k[l * 512 + col];
  const float gnw = p.rw_gn_w[l * 512 + col], gnb = p.rw_gn_b[l * 512 + col];
  const size_t row0 = (size_t)b * SEQ;
  const int r0 = wave * 8 + (lane >> 4) * 2, c = lane & 15;
  f32x2 Sa[2], Sb[2];
#pragma unroll
  for (int i = 0; i < 2; ++i) { Sa[i] = f32x2{0.f, 0.f}; Sb[i] = f32x2{0.f, 0.f}; }
  u16 q_rt[2], q_rp[2], q_kt[2], q_kp[2], q_v[2], q_a[2], q_w[2], q_g[2];
#define RW_LOAD(t0)                                                                                 \
  {                                                                                                 \
    int pin_ = 1;                                                                                   \
    asm volatile("" : "+s"(pin_));                                                                  \
    _Pragma("unroll") for (int i = 0; i < 2; ++i) {                                                 \
      q_rt[i] = 0; q_kt[i] = 0; q_rp[i] = 0; q_kp[i] = 0; q_v[i] = 0; q_a[i] = 0; q_w[i] = 0; q_g[i] = 0; \
    }                                                                                               \
    if (pin_) {                                                                                     \
    _Pragma("unroll") for (int i = 0; i < 2; ++i) {                                                 \
      const int t = (t0) + wave + 8 * i;                                                            \
      const size_t row = row0 + t;                                                                  \
      const u16* pr = p.PROJ + row * PLD;                                                           \
      q_rt[i] = pr[C_R + col]; q_kt[i] = pr[C_K + col];                                             \
      q_rp[i] = t > 0 ? pr[C_R + col - PLD] : (u16)0; q_kp[i] = t > 0 ? pr[C_K + col - PLD] : (u16)0; \
      q_v[i] = p.VF[row * 512 + col]; q_a[i] = p.AA[row * 512 + col];                               \
      q_w[i] = p.WR[row * 512 + col]; q_g[i] = p.GG[row * 512 + col];                               \
    }                                                                                               \
    }                                                                                               \
  }
#define RW_FILL(buf)                                                                                \
  {                                                                                                 \
    _Pragma("unroll") for (int i = 0; i < 2; ++i) {                                                 \
      const int tt = wave + 8 * i;                                                                  \
      const float rt = bf2f(q_rt[i]), kt_ = bf2f(q_kt[i]);                                          \
      const float r = rt + (bf2f(q_rp[i]) - rt) * mu_r;                                             \
      const float kx = kt_ + (bf2f(q_kp[i]) - kt_) * mu_k;                                          \
      const float aa = bf2f(q_a[i]);                                                                \
      const float kkv = kx * kk_w;                                                                  \
      const float nrm = sqrtf(wave_sum(kkv * kkv));                                                 \
      const float kkn = kkv / fmaxf(nrm, 1e-12f);                                                   \
      const float knew = kx * (1.f + (aa - 1.f) * ka_w);                                            \
      const float wl = -softplusf_(-bf2f(q_w[i])) - 0.5f;                                           \
      const float wdec = __expf(-__expf(wl));                                                       \
      float* s = stg + ((buf) * 16 + tt) * 448;                                                     \
      s[lane] = r; s[64 + lane] = wdec; s[128 + lane] = knew; s[192 + lane] = -kkn;                 \
      s[256 + lane] = kkn * aa; s[320 + lane] = bf2f(q_v[i]); s[384 + lane] = bf2f(q_g[i]);         \
      const float bs = wave_sum(r * knew * rk_w);                                                   \
      if (lane == 0) bon[(buf) * 16 + tt] = bs;                                                     \
    }                                                                                               \
  }
  __syncthreads();
  RW_LOAD(0);
  RW_FILL(0);
  __syncthreads();
  for (int ch = 0; ch < SEQ / 16; ++ch) {
    const int buf = ch & 1, t0 = ch * 16;
    {
    if (ch + 1 < SEQ / 16) RW_LOAD(t0 + 16);
    {
      f32x4 op[2][5];
      f32x2 ov[2];
      const float* sb = stg + buf * 16 * 448 + c * 4;
#define RW_LDOPS(tt, q)                                                        \
      {                                                                        \
        const float* s_ = sb + (tt) * 448;                                     \
        _Pragma("unroll") for (int u = 0; u < 5; ++u) op[q][u] = *(const f32x4*)(s_ + 64 * u); \
        ov[q] = *(const f32x2*)(stg + (buf * 16 + (tt)) * 448 + 320 + r0);     \
      }
#define PK_LO(v) __builtin_shufflevector((v), (v), 0, 1)
#define PK_HI(v) __builtin_shufflevector((v), (v), 2, 3)
      RW_LDOPS(0, 0);
#pragma unroll 1
      for (int t2 = 0; t2 < 16; t2 += 2) {
#pragma unroll
      for (int q = 0; q < 2; ++q) {
        const int tt = t2 + q;
        if (q == 0) RW_LDOPS(tt + 1, 1) else if (t2 + 2 < 16) RW_LDOPS(tt + 1, 0);
        f32x2 sA = Sa[0] * PK_LO(op[q][3]); sA += Sa[1] * PK_HI(op[q][3]);
        f32x2 sB = Sb[0] * PK_LO(op[q][3]); sB += Sb[1] * PK_HI(op[q][3]);
        const float saa = red16(sA[0] + sA[1]);
        const float sab = red16(sB[0] + sB[1]);
        const f32x2 saa2 = {saa, saa}, sab2 = {sab, sab};
        const f32x2 va2 = {ov[q][0], ov[q][0]}, vb2 = {ov[q][1], ov[q][1]};
        Sa[0] = Sa[0] * PK_LO(op[q][1]) + saa2 * PK_LO(op[q][4]) + va2 * PK_LO(op[q][2]);
        Sa[1] = Sa[1] * PK_HI(op[q][1]) + saa2 * PK_HI(op[q][4]) + va2 * PK_HI(op[q][2]);
        Sb[0] = Sb[0] * PK_LO(op[q][1]) + sab2 * PK_LO(op[q][4]) + vb2 * PK_LO(op[q][2]);
        Sb[1] = Sb[1] * PK_HI(op[q][1]) + sab2 * PK_HI(op[q][4]) + vb2 * PK_HI(op[q][2]);
        f32x2 yA = Sa[0] * PK_LO(op[q][0]); yA += Sa[1] * PK_HI(op[q][0]);
        f32x2 yB = Sb[0] * PK_LO(op[q][0]); yB += Sb[1] * PK_HI(op[q][0]);
        const float ya = red16(yA[0] + yA[1]);
        const float yb = red16(yB[0] + yB[1]);
        if (c == 0) { f32x2 yy = {ya, yb}; *(f32x2*)(ybuf + tt * 64 + r0) = yy; }
      }
      }
#undef RW_LDOPS
    }
    }
    __syncthreads();
    {
#pragma unroll
    for (int i = 0; i < 2; ++i) {
      const int tt = wave + 8 * i;
      const float y = ybuf[tt * 64 + lane];
      const float mean = wave_sum(y) * (1.f / 64.f);
      const float d = y - mean;
      const float var = wave_sum(d * d) * (1.f / 64.f);
      const float yn = d * rsqrtf(var + 64e-5f) * gnw + gnb;
      const float* s = stg + (buf * 16 + tt) * 448;
      const float o = (yn + bon[buf * 16 + tt] * s[320 + lane]) * s[384 + lane];
      if (!dry) p.GG[(row0 + t0 + tt) * 512 + col] = f2bf(o);
    }
    if (ch + 1 < SEQ / 16) RW_FILL(buf ^ 1);
    }
    __syncthreads();
  }
#undef RW_LOAD
#undef RW_FILL
}

__device__ void ssd_item(const Params& p, int l, int item, char* smem, int dry) {
  const int b = item >> 3, hh = item & 7, g = hh >> 2;
  const int tid = TIDX, lane = tid & 63, wave = tid >> 6;
  constexpr int SS = 456;
  float* stg = (float*)smem;
  float* ybuf = stg + 2 * 16 * SS;
  int chn[5] = {hh * 64 + lane, 512 + g * 128 + lane, 512 + g * 128 + 64 + lane, 768 + g * 128 + lane, 768 + g * 128 + 64 + lane};
  float cw[4][5], cbv[5];
#pragma unroll
  for (int k = 0; k < 5; ++k) {
    cbv[k] = p.conv_b[l * 1024 + chn[k]];
#pragma unroll
    for (int j = 0; j < 4; ++j) cw[j][k] = p.conv_w[(l * 4 + j) * 1024 + chn[k]];
  }
  const float dtb = p.dt_bias[l * 8 + hh];
  const float Aneg = -__expf(p.a_log[l * 8 + hh]);
  const float Dsk = p.ssm_d[l * 8 + hh];
  const size_t row0 = (size_t)b * SEQ;
  const int r0 = wave * 8 + (lane >> 4) * 2, c = lane & 15;
  f32x2 Sa[4], Sb[4];
#pragma unroll
  for (int i = 0; i < 4; ++i) { Sa[i] = f32x2{0.f, 0.f}; Sb[i] = f32x2{0.f, 0.f}; }
  u16 q_x[5][5], q_z[2], q_dt[2];
#define SSD_LOAD(t0)                                                                   \
  {                                                                                    \
    _Pragma("unroll") for (int k = 0; k < 5; ++k) {                                    \
      const int t = (t0) + 2 * wave - 3 + k;                                           \
      const u16* pr = p.PROJ + (row0 + (t < 0 ? 0 : t)) * PLD + C_XBC;                 \
      _Pragma("unroll") for (int j = 0; j < 5; ++j) q_x[k][j] = t >= 0 ? pr[chn[j]] : (u16)0; \
    }                                                                                  \
    int pin_ = 1;                                                                      \
    asm volatile("" : "+s"(pin_));                                                     \
    q_z[0] = 0; q_z[1] = 0; q_dt[0] = 0; q_dt[1] = 0;                                  \
    if (pin_) {                                                                        \
    _Pragma("unroll") for (int i = 0; i < 2; ++i) {                                    \
      const u16* pr = p.PROJ + (row0 + (t0) + 2 * wave + i) * PLD;                     \
      q_z[i] = pr[C_Z + hh * 64 + lane]; q_dt[i] = pr[C_DT + hh];                      \
    }                                                                                  \
    }                                                                                  \
  }
#define SSD_FILL(buf)                                                                  \
  {                                                                                    \
    _Pragma("unroll") for (int i = 0; i < 2; ++i) {                                    \
      float cv[5];                                                                     \
      _Pragma("unroll") for (int j = 0; j < 5; ++j) {                                  \
        float a = cbv[j];                                                              \
        _Pragma("unroll") for (int k = 0; k < 4; ++k) a += cw[k][j] * bf2f(q_x[i + k][j]); \
        cv[j] = siluf_(a);                                                             \
      }                                                                                \
      const float dt = softplusf_(bf2f(q_dt[i]) + dtb);                                \
      float* s = stg + ((buf) * 16 + 2 * wave + i) * SS;                               \
      s[lane] = cv[1]; s[64 + lane] = cv[2]; s[128 + lane] = cv[3]; s[192 + lane] = cv[4]; \
      s[256 + lane] = cv[0] * dt; s[320 + lane] = cv[0]; s[384 + lane] = bf2f(q_z[i]); \
      if (lane == 0) s[448] = __expf(dt * Aneg);                                       \
    }                                                                                  \
  }
  __syncthreads();
  SSD_LOAD(0);
  SSD_FILL(0);
  __syncthreads();
  for (int ch = 0; ch < SEQ / 16; ++ch) {
    const int buf = ch & 1, t0 = ch * 16;
    {
    if (ch + 1 < SEQ / 16) SSD_LOAD(t0 + 16);
    {
      f32x4 op[2][4];
      f32x2 oxd[2];
      float oda[2];
      const float* sb = stg + buf * 16 * SS;
#define SSD_LDOPS(tt, q)                                                       \
      {                                                                        \
        const float* s_ = sb + (tt) * SS;                                      \
        op[q][0] = *(const f32x4*)(s_ + c * 8);                                \
        op[q][1] = *(const f32x4*)(s_ + c * 8 + 4);                            \
        op[q][2] = *(const f32x4*)(s_ + 128 + c * 8);                          \
        op[q][3] = *(const f32x4*)(s_ + 128 + c * 8 + 4);                      \
        oxd[q] = *(const f32x2*)(s_ + 256 + r0);                               \
        oda[q] = s_[448];                                                      \
      }
      SSD_LDOPS(0, 0);
#pragma unroll 1
      for (int t2 = 0; t2 < 16; t2 += 2) {
#pragma unroll
      for (int q = 0; q < 2; ++q) {
        const int tt = t2 + q;
        if (q == 0) SSD_LDOPS(tt + 1, 1) else if (t2 + 2 < 16) SSD_LDOPS(tt + 1, 0);
        const f32x2 dA2 = {oda[q], oda[q]};
        const f32x2 xa2 = {oxd[q][0], oxd[q][0]}, xb2 = {oxd[q][1], oxd[q][1]};
        const f32x2 B2[4] = {PK_LO(op[q][0]), PK_HI(op[q][0]), PK_LO(op[q][1]), PK_HI(op[q][1])};
        const f32x2 C2[4] = {PK_LO(op[q][2]), PK_HI(op[q][2]), PK_LO(op[q][3]), PK_HI(op[q][3])};
        f32x2 yA = {0.f, 0.f}, yB = {0.f, 0.f};
#pragma unroll
        for (int j = 0; j < 4; ++j) {
          Sa[j] = Sa[j] * dA2 + xa2 * B2[j];
          Sb[j] = Sb[j] * dA2 + xb2 * B2[j];
          yA += Sa[j] * C2[j];
          yB += Sb[j] * C2[j];
        }
        const float ya = red16(yA[0] + yA[1]);
        const float yb = red16(yB[0] + yB[1]);
        if (c == 0) { f32x2 yy = {ya, yb}; *(f32x2*)(ybuf + tt * 64 + r0) = yy; }
      }
      }
#undef SSD_LDOPS
    }
    }
    __syncthreads();
    {
#pragma unroll
    for (int i = 0; i < 2; ++i) {
      const int tt = wave + 8 * i;
      const float* s = stg + (buf * 16 + tt) * SS;
      const float y = ybuf[tt * 64 + lane] + Dsk * s[320 + lane];
      const float zz = s[384 + lane];
      if (!dry) p.PROJ[(row0 + t0 + tt) * PLD + C_Z + hh * 64 + lane] = f2bf(y * siluf_(zz));
    }
    if (ch + 1 < SEQ / 16) SSD_FILL(buf ^ 1);
    }
    __syncthreads();
  }
#undef SSD_LOAD
#undef SSD_FILL
}

__device__ void attn_item(const Params& p, int l, int item, char* smem, int dry) {
  const int hp = item & 3, qb = (item >> 2) & 15, b = item >> 6;
  const int kvh = hp >> 1;
  u16* Ks = (u16*)smem;
  u16* Vt = (u16*)(smem + 256 * 72 * 2);
  float* invd = (float*)(smem + 256 * 72 * 2 + 64 * 264 * 2);
  const int tid = TIDX, lane = tid & 63, wave = tid >> 6, wq = wave & 3, l31 = lane & 31, h = lane >> 5;
  const int hq = hp * 2 + (wave >> 2);
  const size_t rowq0 = (size_t)b * SEQ + qb * 128;
  const long rowk0 = (long)rowq0 - 128;
  __syncthreads();
#pragma unroll
  for (int i = 0; i < 4; ++i) {
    const int cidx = tid + NTHR * i;
    const int key = cidx >> 3, cc = cidx & 7;
    uint4 v = {0u, 0u, 0u, 0u};
    if (qb > 0 || key >= 128) v = *(const uint4*)(p.PROJ + (size_t)(rowk0 + key) * PLD + C_AK + kvh * 64 + cc * 8);
    *(uint4*)(Ks + key * 72 + cc * 8) = v;
  }
#pragma unroll
  for (int i = 0; i < 4; ++i) {
    const int key = (tid & 63) + 64 * i;
    const int dc = tid >> 6;
    uint4 v = {0u, 0u, 0u, 0u};
    if (qb > 0 || key >= 128) v = *(const uint4*)(p.PROJ + (size_t)(rowk0 + key) * PLD + C_AV + kvh * 64 + dc * 8);
    const unsigned e[4] = {v.x, v.y, v.z, v.w};
#pragma unroll
    for (int j = 0; j < 4; ++j) {
      Vt[(dc * 8 + 2 * j) * 264 + key] = (u16)(e[j] & 0xffffu);
      Vt[(dc * 8 + 2 * j + 1) * 264 + key] = (u16)(e[j] >> 16);
    }
  }
  __syncthreads();
  const u16* qptr = p.PROJ + (rowq0 + wq * 32 + l31) * PLD + C_Q + hq * 64 + h * 8;
  bf16x8 qf[4];
#pragma unroll
  for (int ks = 0; ks < 4; ++ks) qf[ks] = *(const bf16x8*)(qptr + ks * 16);
  f32x16 sc[5];
#pragma unroll
  for (int i = 0; i < 5; ++i) {
#pragma unroll
    for (int r = 0; r < 16; ++r) sc[i][r] = 0.f;
    const u16* kp = Ks + ((wq + i) * 32 + l31) * 72 + h * 8;
#pragma unroll
    for (int ks = 0; ks < 4; ++ks) {
      const bf16x8 kf = *(const bf16x8*)(kp + ks * 16);
      sc[i] = MFMA(kf, qf[ks], sc[i]);
    }
  }
  const int qi = wq * 32 + l31;
  const float sink = p.sinks[l * 8 + hq];
  float m = sink;
#pragma unroll
  for (int i = 0; i < 5; ++i)
#pragma unroll
    for (int r = 0; r < 16; ++r) {
      const int j = (wq + i) * 32 + crow(r, h);
      const int rel = qi + 128 - j;
      const bool valid = (rel >= 0) && (rel < 128) && (qb > 0 || j >= 128);
      const float s = valid ? sc[i][r] * 0.125f : -INFINITY;
      sc[i][r] = s;
      m = fmaxf(m, s);
    }
  m = fmaxf(m, __shfl_xor(m, 32));
  float sum = 0.f;
#pragma unroll
  for (int i = 0; i < 5; ++i)
#pragma unroll
    for (int r = 0; r < 16; ++r) {
      const float pv = __expf(sc[i][r] - m);
      sc[i][r] = pv;
      sum += pv;
    }
  sum += __shfl_xor(sum, 32);
  const float denom = sum + __expf(sink - m);
  if (h == 0) invd[(wave >> 2) * 128 + qi] = 1.f / denom;
  f32x16 o[2];
#pragma unroll
  for (int db = 0; db < 2; ++db)
#pragma unroll
    for (int r = 0; r < 16; ++r) o[db][r] = 0.f;
#pragma unroll
  for (int i = 0; i < 5; ++i)
#pragma unroll
    for (int s2 = 0; s2 < 2; ++s2) {
      bf16x8 pa;
#pragma unroll
      for (int j = 0; j < 8; ++j) pa[j] = (short)f2bf(sc[i][8 * s2 + j]);
#pragma unroll
      for (int db = 0; db < 2; ++db) {
        const u16* vp = Vt + (db * 32 + l31) * 264 + (wq + i) * 32 + 16 * s2 + 4 * h;
        const s16x4 lo = *(const s16x4*)vp;
        const s16x4 hi = *(const s16x4*)(vp + 8);
        const bf16x8 vf = __builtin_shufflevector(lo, hi, 0, 1, 2, 3, 4, 5, 6, 7);
        o[db] = MFMA(pa, vf, o[db]);
      }
    }
  __syncthreads();
#pragma unroll
  for (int db = 0; db < 2; ++db)
#pragma unroll
    for (int r = 0; r < 16; ++r) {
      const int q = wq * 32 + crow(r, h);
      if (!dry) p.PROJ[(rowq0 + q) * PLD + C_Q + hq * 64 + db * 32 + l31] = f2bf(o[db][r] * invd[(wave >> 2) * 128 + q]);
    }
}

__device__ void phase_attn(const Params& p, int l, char* smem, int dry) {
  for (int it = BIDX; it < 1024; it += GDIM) attn_item(p, l, it, smem, dry);
}
__device__ void phase_mix(const Params& p, int l, char* smem, int dry) {
  for (int it = BIDX; it < 256; it += GDIM) {
    if (it < 128) rwkv_item(p, l, it, smem, dry);
    else ssd_item(p, l, it - 128, smem, dry);
  }
}

__device__ void phase_post(const Params& p, int l, char* smem) {
  cvt_T(p.w_gu + (size_t)l * DM * 2 * FH, 1024, 2 * FH, 0, 2 * FH, p.WguT, XLD, 0, 1, smem);
  cvt_T(p.w_down + (size_t)l * FH * DM, FH, 1024, 0, 1024, p.WdownT, FH, 0, 0, smem);
  const int lane = TIDX & 63;
  const int gw = BIDX * NWV + (TIDX >> 6), nw = GDIM * NWV;
  const float* nwp = p.ssm_norm_w + l * 512 + lane * 8;
  for (int row = gw; row < M_TOK; row += nw) {
    u16* pz = p.PROJ + (size_t)row * PLD + C_Z + lane * 8;
    const uint4 raw = *(const uint4*)pz;
    const unsigned e[4] = {raw.x, raw.y, raw.z, raw.w};
    float v[8];
    float ss = 0.f;
#pragma unroll
    for (int j = 0; j < 4; ++j) {
      v[2 * j] = bf2f((u16)(e[j] & 0xffffu));
      v[2 * j + 1] = bf2f((u16)(e[j] >> 16));
      ss += v[2 * j] * v[2 * j] + v[2 * j + 1] * v[2 * j + 1];
    }
#pragma unroll
    for (int o = 16; o > 0; o >>= 1) ss += __shfl_xor(ss, o);
    const float rstd = rsqrtf(ss * (1.f / 256.f) + 1e-6f);
    uint4 ov;
    ov.x = pack2(v[0] * rstd * nwp[0], v[1] * rstd * nwp[1]);
    ov.y = pack2(v[2] * rstd * nwp[2], v[3] * rstd * nwp[3]);
    ov.z = pack2(v[4] * rstd * nwp[4], v[5] * rstd * nwp[5]);
    ov.w = pack2(v[6] * rstd * nwp[6], v[7] * rstd * nwp[7]);
    *(uint4*)pz = ov;
  }
}

__device__ void phase_G2(const Params& p, int l, char* smem) {
  const int lane = TIDX & 63, wave = TIDX >> 6, wn = wave & 1, fq = lane >> 4;
  u32x4 ra[4], rw[2];
  bool pre = false;
  int mt, nt;
  bool have = next_tile(0, 128, 8, mt, nt);
  for (int k = 0; have; ++k) {
    int mt2 = 0, nt2 = 0;
    const bool have2 = next_tile(k + 1, 128, 8, mt2, nt2);
    const int m0 = mt * 256, n0 = nt * 128;
    f32x4 tot[4][4];
    zero_acc<2>(tot);
#pragma unroll 1
    for (int br = 0; br < 3; ++br) {
      const u16* Ab; int lda;
      if (br == 0) { Ab = p.GG + (size_t)m0 * 512; lda = 512; }
      else if (br == 1) { Ab = p.PROJ + (size_t)m0 * PLD + C_Z; lda = PLD; }
      else { Ab = p.PROJ + (size_t)m0 * PLD + C_Q; lda = PLD; }
      const u16* Wb = p.WbrT + ((size_t)br * 1024 + n0) * 512;
      f32x4 ac[4][4];
      zero_acc<2>(ac);
      gemm_core<2>(ac, p.XN + (size_t)m0 * XLD, XLD, p.WgT + ((size_t)br * 1024 + n0) * XLD, XLD, DM, smem, ra, rw, pre,
                   Ab, lda, Wb, 512);
      unsigned sg[4][4][2];
      const float* gb = p.gate_b + l * 3072 + br * 1024 + n0 + wn * 64 + fq * 4;
#pragma unroll
      for (int nb = 0; nb < 4; ++nb) {
        const f32x4 bias = *(const f32x4*)(gb + nb * 16);
#pragma unroll
        for (int mb = 0; mb < 4; ++mb) {
          sg[nb][mb][0] = cvt_pk_bf16(sigmoidf_(ac[nb][mb][0] + bias[0]), sigmoidf_(ac[nb][mb][1] + bias[1]));
          sg[nb][mb][1] = cvt_pk_bf16(sigmoidf_(ac[nb][mb][2] + bias[2]), sigmoidf_(ac[nb][mb][3] + bias[3]));
        }
      }
      zero_acc<2>(ac);
      const bool more = br < 2 || have2;
      const int m0n = br < 2 ? m0 : mt2 * 256, n0n = br < 2 ? n0 : nt2 * 128, brn = br < 2 ? br + 1 : 0;
      gemm_core<2>(ac, Ab, lda, Wb, 512, 512, smem, ra, rw, true,
                   more ? p.XN + (size_t)m0n * XLD : nullptr, XLD, p.WgT + ((size_t)brn * 1024 + n0n) * XLD, XLD);
      pre = more;
#pragma unroll
      for (int nb = 0; nb < 4; ++nb)
#pragma unroll
        for (int mb = 0; mb < 4; ++mb) {
          tot[nb][mb][0] += __uint_as_float(sg[nb][mb][0] << 16) * ac[nb][mb][0];
          tot[nb][mb][1] += __uint_as_float(sg[nb][mb][0] & 0xffff0000u) * ac[nb][mb][1];
          tot[nb][mb][2] += __uint_as_float(sg[nb][mb][1] << 16) * ac[nb][mb][2];
          tot[nb][mb][3] += __uint_as_float(sg[nb][mb][1] & 0xffff0000u) * ac[nb][mb][3];
        }
    }
    u16* dst = p.MERGED + (size_t)m0 * DM + n0;
    epilogue_bf16<2>(tot, smem, dst, DM, [&](int, int, f32x4 v) { return v; });
    mt = mt2; nt = nt2; have = have2;
  }
}

__device__ void phase_resid(const Params& p, const u16* A, int K, const u16* W, int ldw, char* smem, int dry) {
  for (int k = 0;; ++k) {
    int mt, nt;
    if (!next_tile(k, 128, 4, mt, nt)) break;
    f32x4 acc[8][4];
    zero_acc<4>(acc);
    gemm_core<4>(acc, A + (size_t)mt * 256 * K, K, W + (size_t)nt * 256 * ldw, ldw, K, smem);
    float* dst = p.out + (size_t)mt * 256 * DM + nt * 256;
    epilogue<4>(acc, smem, [&](int row, int col, f32x4 v) {
      f32x4* px = (f32x4*)(dst + (size_t)row * DM + col);
      f32x4 x = *px;
      x[0] += v[0]; x[1] += v[1]; x[2] += v[2]; x[3] += v[3];
      if (!dry) *px = x;
    });
  }
}

__device__ void phase_G4(const Params& p, char* smem) {
  u32x4 ra[4], rw[4];
  bool pre = false;
  int mt, nt;
  bool have = next_tile(0, 128, 22, mt, nt);
  for (int k = 0; have; ++k) {
    int mt2 = 0, nt2 = 0;
    const bool have2 = next_tile(k + 1, 128, 22, mt2, nt2);
    f32x4 acc[8][4];
    zero_acc<4>(acc);
    gemm_core<4>(acc, p.XN + (size_t)mt * 256 * XLD, XLD, p.WguT + (size_t)nt * 256 * XLD, XLD, DM, smem, ra, rw, pre,
                 have2 ? p.XN + (size_t)mt2 * 256 * XLD : nullptr, XLD, p.WguT + (size_t)nt2 * 256 * XLD, XLD);
    pre = have2;
    f32x4 hv[4][4];
#pragma unroll
    for (int pb = 0; pb < 4; ++pb) {
      const int nbg = (pb >> 1) * 4 + (pb & 1);
#pragma unroll
      for (int mb = 0; mb < 4; ++mb)
#pragma unroll
        for (int j = 0; j < 4; ++j) hv[pb][mb][j] = siluf_(acc[nbg][mb][j]) * acc[nbg + 2][mb][j];
    }
    u16* dst = p.H + (size_t)mt * 256 * FH + nt * 128;
    epilogue_bf16<2>(hv, smem, dst, FH, [&](int, int, f32x4 v) { return v; });
    mt = mt2; nt = nt2; have = have2;
  }
}

__device__ void phase_final(const Params& p) { rmsnorm_rows(p.out, p.norm_final, nullptr, p.out); }

DI void grid_barrier(unsigned* bar, unsigned target) {
  __syncthreads();
  if (TIDX == 0) {
    __threadfence();
    __hip_atomic_fetch_add(bar, 1u, __ATOMIC_RELAXED, __HIP_MEMORY_SCOPE_AGENT);
    while (__hip_atomic_load(bar, __ATOMIC_RELAXED, __HIP_MEMORY_SCOPE_AGENT) < target) __builtin_amdgcn_s_sleep(4);
    __threadfence();
  }
  __syncthreads();
}

#define XB_TMO      128
#define XB_XCNT(j)  (256  + 64 * (j))
#define XB_XSUB(j)  (1280 + 64 * (j))
#define XB_XGEN(j)  (2304 + 64 * (j))
#define XB_TOP      3328
#define XB_TOPGEN   3392
#define XCD_BAR_WORDS 3456
#define XB_SPIN_CAP (1u << 20)
#define LAS __attribute__((address_space(3)))
DI unsigned xb_ld(unsigned* p) { return __hip_atomic_load(p, __ATOMIC_RELAXED, __HIP_MEMORY_SCOPE_AGENT); }
DI unsigned xb_add(unsigned* p, unsigned v) { return __hip_atomic_fetch_add(p, v, __ATOMIC_RELAXED, __HIP_MEMORY_SCOPE_AGENT); }
DI unsigned xb_xcc_id() { return (unsigned)__builtin_amdgcn_s_getreg((3 << 11) | 20) & 0xFu; }
#define XB_SPIN(cond, bar) do { unsigned _sp = 0; while (cond) { __builtin_amdgcn_s_sleep(1); \
    if ((++_sp & 255u) == 0u) { if (xb_ld(&(bar)[XB_TMO])) break; if (_sp > XB_SPIN_CAP) { atomicAdd(&(bar)[XB_TMO], 1u); break; } } } } while (0)
DI void xcd_barrier_post(unsigned* bar) {
  if (threadIdx.x == 0) (void)xb_add(&bar[XB_XCNT(xb_xcc_id())], 1u);
}
DI void xcd_barrier_complete(unsigned* bar, unsigned x, unsigned& nloc, unsigned& nx) {
  const unsigned G = gridDim.x;
  unsigned sum, cnt, mine, sp = 0u;
  for (;;) {
    sum = 0u; cnt = 0u; mine = 0u;
#pragma unroll
    for (unsigned j = 0; j < 16; ++j) { const unsigned c = xb_ld(&bar[XB_XCNT(j)]); sum += c; cnt += (c > 0u) ? 1u : 0u; mine = (j == x) ? c : mine; }
    if (sum == G) break;
    __builtin_amdgcn_s_sleep(1);
    if ((++sp & 255u) == 0u) { if (xb_ld(&bar[XB_TMO])) break; if (sp > XB_SPIN_CAP) { atomicAdd(&bar[XB_TMO], 1u); break; } }
  }
  nloc = mine > 0u ? mine : 1u; nx = cnt > 0u ? cnt : 1u;
}
DI void xcd_barrier(unsigned* bar, volatile LAS unsigned* st) {
  asm volatile("s_waitcnt vmcnt(0)" ::: "memory");
  __syncthreads();
  if (threadIdx.x == 0) {
    __builtin_amdgcn_s_waitcnt(0);
    const unsigned x = xb_xcc_id();
    unsigned nloc = st[0], nx = st[1];
    if (nloc == 0u) { xcd_barrier_complete(bar, x, nloc, nx); st[0] = nloc; st[1] = nx; }
    const unsigned old = xb_add(&bar[XB_XSUB(x)], 1u);
    const unsigned gen = old / nloc;
    if (old + 1u == (gen + 1u) * nloc) {
      __builtin_amdgcn_fence(__ATOMIC_RELEASE, "agent");
      asm volatile("s_waitcnt vmcnt(0)" ::: "memory");
      const unsigned og = xb_add(&bar[XB_TOP], 1u);
      const unsigned tg = og / nx;
      if (og + 1u == (tg + 1u) * nx) xb_add(&bar[XB_TOPGEN], 1u);
      else XB_SPIN(xb_ld(&bar[XB_TOPGEN]) == tg, bar);
      __builtin_amdgcn_fence(__ATOMIC_ACQUIRE, "agent");
      xb_add(&bar[XB_XGEN(x)], 1u);
      asm volatile("s_waitcnt vmcnt(0)" ::: "memory");
    } else {
      XB_SPIN(xb_ld(&bar[XB_XGEN(x)]) == gen, bar);
      __builtin_amdgcn_fence(__ATOMIC_ACQUIRE, "agent");
      asm volatile("s_waitcnt vmcnt(0)" ::: "memory");
    }
  }
  __syncthreads();
}

constexpr int NPH = 12;
DI void run_phase(const Params& p, int l, int ph, char* smem, int dry = 0) {
  asm volatile("" : "+s"(l));
  switch (ph) {
    case 0: phase_A(p, l, smem); break;
    case 1: phase_G1(p, smem); break;
    case 2: phase_pre(p, l); break;
    case 3: phase_prep(p, l, smem); break;
    case 4: phase_mix(p, l, smem, dry); break;
    case 11: phase_attn(p, l, smem, dry); break;
    case 5: phase_post(p, l, smem); break;
    case 6: phase_G2(p, l, smem); break;
    case 7: phase_resid(p, p.MERGED, DM, p.WoutT, XLD, smem, dry); break;
    case 8: rmsnorm_rows(p.out, p.norm_ffn + l * DM, p.XN, nullptr); break;
    case 9: phase_G4(p, smem); break;
    case 10: phase_resid(p, p.H, FH, p.WdownT, FH, smem, dry); break;
    default: break;
  }
}

#if MULTI
template <int PH>
__global__ void __launch_bounds__(NTHR) k_phase(Params p, int l) {
  __shared__ __attribute__((aligned(16))) char smem[SMEM_BYTES];
  if (PH < NPH) run_phase(p, l, PH, smem);
  else phase_final(p);
}
#else
__global__ void __launch_bounds__(NTHR) k_mega(Params p) {
  __shared__ __attribute__((aligned(16))) char smem[SMEM_BYTES];
  cg::grid_group grid = cg::this_grid();
  __shared__ uint4 xb_words;
  if (threadIdx.x == 0) xb_words = make_uint4(0u, 0u, 0u, 0u);
  __syncthreads();
  unsigned* bar = (unsigned*)p.ctr;
  if (blockIdx.x == 0) for (int i = threadIdx.x; i < XCD_BAR_WORDS; i += NTHR) bar[i] = 0u;
  for (int l = 0; l < 2; ++l) {
#pragma unroll 1
    for (int i = 0; i < NPH; ++i) {
      const int ph = i < 4 ? i : (i == 4 ? 11 : i - 1);
      run_phase(p, l, ph, smem);
      if (l == 0 && i == 0) { grid.sync(); xcd_barrier_post(bar); }
      else xcd_barrier(bar, (volatile LAS unsigned*)&xb_words);
    }
  }
  phase_final(p);
}
#endif

extern "C" void kernel_launch(void* const* d_in, const int* in_sizes, int n_in, void* d_out, int out_size, void* d_ws, size_t ws_size,
                              hipStream_t stream) {
  Params p{};
  const float** pf = (const float**)&p;
  for (int i = 0; i < 34; ++i) pf[i] = (const float*)d_in[i];
  p.out = (float*)d_out;
  char* ws = (char*)d_ws;
  size_t off = 0;
  auto take = [&](size_t bytes) { char* r = ws + off; off += (bytes + 255) & ~(size_t)255; return r; };
  p.ctr = (int*)take(16384);
  p.WinT = (u16*)take((size_t)PLD * XLD * 2);
  p.WgT = (u16*)take((size_t)3072 * XLD * 2);
  p.WbrT = (u16*)take((size_t)3 * 1024 * 512 * 2);
  p.WoutT = (u16*)take((size_t)1024 * XLD * 2);
  p.w2T = (u16*)take(512 * 64 * 2);
  p.a2T = (u16*)take(512 * 64 * 2);
  p.g2T = (u16*)take(512 * 192 * 2);
  p.v2T = (u16*)take(512 * 64 * 2);
  char* shared = take((size_t)M_TOK * LALD * 2);
  p.LA = (u16*)shared;
  p.WguT = (u16*)shared;
  p.WdownT = (u16*)(shared + (size_t)2 * FH * XLD * 2);
  p.XN = (u16*)take((size_t)M_TOK * XLD * 2);
  p.PROJ = (u16*)take((size_t)M_TOK * PLD * 2);
  p.H = p.PROJ;
  p.VF = (u16*)take((size_t)M_TOK * 512 * 2);
  p.AA = (u16*)take((size_t)M_TOK * 512 * 2);
  p.WR = (u16*)take((size_t)M_TOK * 512 * 2);
  p.GG = (u16*)take((size_t)M_TOK * 512 * 2);
  p.MERGED = p.AA;
  if (off > ws_size || n_in != 34) { fprintf(stderr, "kernel_launch: workspace too small (%zu needed, %zu given) or n_in %d\n", off, ws_size, n_in); return; }
#if MULTI
#define LP(PH) hipLaunchKernelGGL(k_phase<PH>, dim3(256), dim3(NTHR), 0, stream, p, l)
  for (int l = 0; l < 2; ++l) { LP(0); LP(1); LP(2); LP(3); LP(11); LP(4); LP(5); LP(6); LP(7); LP(8); LP(9); LP(10); }
  { int l = 0; LP(12); }
#else
  static int grid = 0;
  if (!grid) {
    int dev = 0, cus = 0, per_cu = 0;
    hipGetDevice(&dev);
    hipDeviceGetAttribute(&cus, hipDeviceAttributeMultiprocessorCount, dev);
    (void)hipOccupancyMaxActiveBlocksPerMultiprocessor(&per_cu, k_mega, NTHR, 0);
    if (per_cu < 1) per_cu = 1;
    if (per_cu > 1) per_cu = 1;
    grid = cus * per_cu;
  }
  void* args[] = {&p};
  hipError_t e = hipLaunchCooperativeKernel((void*)k_mega, dim3(grid), dim3(NTHR), args, 0, stream);
  if (e != hipSuccess) fprintf(stderr, "cooperative launch failed: %s (grid %d)\n", hipGetErrorString(e), grid);
#endif
}
```

```cpp
#include <hip/hip_runtime.h>
#include <hip/hip_cooperative_groups.h>
#include <cstdio>
#include <cstdint>
namespace cg = cooperative_groups;

#ifndef MULTI
#define MULTI 0
#endif

typedef unsigned short u16;
typedef short bf16x8 __attribute__((ext_vector_type(8)));
typedef short s16x4 __attribute__((ext_vector_type(4)));
typedef float f32x16 __attribute__((ext_vector_type(16)));
typedef float f32x4 __attribute__((ext_vector_type(4)));
typedef float f32x2 __attribute__((ext_vector_type(2)));
typedef unsigned u32x4 __attribute__((ext_vector_type(4)));

#define DI __device__ __forceinline__
#define MFMA(a, b, c) __builtin_amdgcn_mfma_f32_32x32x16_bf16((a), (b), (c), 0, 0, 0)
#define MFMA16(a, b, c) __builtin_amdgcn_mfma_f32_16x16x32_bf16((a), (b), (c), 0, 0, 0)

constexpr int M_TOK = 32768;
constexpr int SEQ = 2048;
constexpr int DM = 1024;
constexpr int PLD = 4224;
constexpr int C_R = 0, C_K = 512, C_V = 1024, C_LW = 1536, C_LA = 1600, C_LG = 1664;
constexpr int C_LV = 1824, C_Z = 1856, C_XBC = 2368, C_DT = 3392, C_Q = 3456, C_AK = 3968, C_AV = 4096;
constexpr int LALD = 384;
constexpr int XLD = 1088;
constexpr int FH = 2816;
constexpr int SMEM_BYTES = 147456;
constexpr int NTHR = 512;
constexpr int NWV = 8;

struct Params {
  const float* x; const float* norm_mix; const float* w_in; const float* rw_mu; const float* rw_w0; const float* rw_w2;
  const float* rw_a0; const float* rw_a2; const float* rw_g2; const float* rw_k_k; const float* rw_k_a; const float* rw_r_k;
  const float* rw_gn_w; const float* rw_gn_b; const float* vres_down; const float* vres_mu; const float* vres_v0; const float* vres_v2;
  const float* conv_w; const float* conv_b; const float* dt_bias; const float* a_log; const float* ssm_d; const float* ssm_norm_w;
  const float* sinks; const float* gate_b; const float* w_br_rw; const float* w_br_ssm; const float* w_br_att; const float* w_out;
  const float* norm_ffn; const float* w_gu; const float* w_down; const float* norm_final;
  float* out;
  u16 *WinT, *WgT, *WbrT, *WoutT, *w2T, *a2T, *g2T, *v2T, *WguT, *WdownT, *LA, *XN, *PROJ, *VF, *AA, *WR, *GG, *MERGED, *H;
  int* ctr;
};

DI int tidx_() { int t = (int)__builtin_amdgcn_workitem_id_x(); asm volatile("" : "+v"(t)); return t; }
DI int bidx_() { int t = (int)__builtin_amdgcn_workgroup_id_x(); asm volatile("" : "+s"(t)); return t; }
DI int gdim_() { int t = (int)gridDim.x; asm volatile("" : "+s"(t)); return t; }
#define TIDX tidx_()
#define BIDX bidx_()
#define GDIM gdim_()

DI float bf2f(u16 v) { return __uint_as_float(((unsigned)v) << 16); }
DI u16 f2bf(float f) { unsigned u = __float_as_uint(f); u += 0x7fffu + ((u >> 16) & 1u); return (u16)(u >> 16); }
DI unsigned pack2(float a, float b) { return (unsigned)f2bf(a) | ((unsigned)f2bf(b) << 16); }
DI unsigned cvt_pk_bf16(float a, float b) { unsigned r; asm volatile("s_nop 4\n\tv_cvt_pk_bf16_f32 %0, %1, %2\n\ts_nop 1" : "=v"(r) : "v"(a), "v"(b)); return r; }
DI float sigmoidf_(float x) { return __builtin_amdgcn_rcpf(1.f + __expf(-x)); }
DI float siluf_(float x) { return x * sigmoidf_(x); }
DI float tanhf_(float x) { return 1.f - 2.f * __builtin_amdgcn_rcpf(1.f + __expf(2.f * x)); }
DI float softplusf_(float z) { return z > 20.f ? z : __logf(1.f + __expf(z)); }
DI int crow(int r, int h) { return (r & 3) + 8 * (r >> 2) + 4 * h; }
DI float dppf(float x, const int ctrl_sel) {
  int xi = __float_as_int(x);
  int r;
  if (ctrl_sel == 0) r = __builtin_amdgcn_update_dpp(0, xi, 0xB1, 0xF, 0xF, true);
  else if (ctrl_sel == 1) r = __builtin_amdgcn_update_dpp(0, xi, 0x4E, 0xF, 0xF, true);
  else r = __builtin_amdgcn_update_dpp(0, xi, 0x141, 0xF, 0xF, true);
  return __int_as_float(r);
}
DI float red8(float x) {
  x += dppf(x, 0);
  x += dppf(x, 1);
  x += dppf(x, 2);
  return x;
}
DI float red16(float x) {
  x = red8(x);
  x += __int_as_float(__builtin_amdgcn_update_dpp(0, __float_as_int(x), 0x140, 0xF, 0xF, true));
  return x;
}
DI float wave_sum(float v) {
  v = red8(v);
  v += __int_as_float(__builtin_amdgcn_update_dpp(0, __float_as_int(v), 0x140, 0xF, 0xF, true));
  const float r0 = __int_as_float(__builtin_amdgcn_readlane(__float_as_int(v), 0));
  const float r1 = __int_as_float(__builtin_amdgcn_readlane(__float_as_int(v), 16));
  const float r2 = __int_as_float(__builtin_amdgcn_readlane(__float_as_int(v), 32));
  const float r3 = __int_as_float(__builtin_amdgcn_readlane(__float_as_int(v), 48));
  return (r0 + r1) + (r2 + r3);
}

__device__ void cvt_T(const float* __restrict__ src, int K, int ld, int c0, int ncols, u16* __restrict__ dst, int dld, int r0,
                      int mode, char* smem) {
  float* tl = (float*)smem;
  const int ct = (ncols + 31) >> 5, kt = (K + 63) >> 6;
  const int tid = TIDX;
  const int nt = ct * kt, gd = GDIM;
  const int rk = tid >> 5, rc = tid & 31;
  float v[4];
  auto LOADT = [&](int t) {
    const int cb = (t % ct) * 32, kb = (t / ct) * 64;
#pragma unroll
    for (int i = 0; i < 4; ++i) {
      const int k = rk + 16 * i;
      v[i] = 0.f;
      if (cb + rc < ncols && kb + k < K) v[i] = src[(size_t)(kb + k) * ld + c0 + cb + rc];
    }
  };
  int t = BIDX;
  if (t < nt) LOADT(t);
  for (; t < nt; t += gd) {
    const int cb = (t % ct) * 32, kb = (t / ct) * 64;
    __syncthreads();
#pragma unroll
    for (int i = 0; i < 4; ++i) tl[rc * 65 + rk + 16 * i] = v[i];
    __syncthreads();
    if (t + gd < nt) LOADT(t + gd);
    {
      const int c = tid >> 4, kc = tid & 15;
      if (cb + c < ncols) {
        int drow;
        if (mode == 0) drow = r0 + cb + c;
        else { const int ty = cb >= FH ? 1 : 0; const int j0 = cb - ty * FH; drow = (j0 >> 5) * 64 + ty * 32 + c; }
        const float* sp = tl + c * 65 + kc * 4;
        uint2 o; o.x = pack2(sp[0], sp[1]); o.y = pack2(sp[2], sp[3]);
        *(uint2*)(dst + (size_t)drow * dld + kb + kc * 4) = o;
      }
    }
  }
  __syncthreads();
}

template <int NI>
DI void gemm_core(f32x4 (&acc)[2 * NI][4], const u16* __restrict__ A, int lda, const u16* __restrict__ W, int ldw, int K, char* smem,
                  u32x4 (&ra)[4], u32x4 (&rw)[NI], bool pre, const u16* nA, int nlda, const u16* nW, int nldw) {
  constexpr int A_ELEMS = 256 * 64;
  constexpr int W_ELEMS = 64 * NI * 64;
  u16* As = (u16*)smem;
  u16* Ws = As + 2 * A_ELEMS;
  const int tid = TIDX, lane = tid & 63, wave = tid >> 6;
  const int wm = wave >> 1, wn = wave & 1, fr = lane & 15, fq = lane >> 4;
  const int lr = tid >> 3, lc = tid & 7;
  unsigned opq = 0;
  asm volatile("" : "+v"(opq));
  const u16* ag = A + (size_t)lr * lda + lc * 8 + opq;
  const u16* wg = W + (size_t)lr * ldw + lc * 8 + opq;
  const int sw_st = (lc ^ ((lr >> 1) & 7)) * 8;
  auto GLOAD = [&](int k0) {
#pragma unroll
    for (int i = 0; i < 4; ++i) ra[i] = *(const u32x4*)(ag + (size_t)(64 * i) * lda + k0);
#pragma unroll
    for (int i = 0; i < NI; ++i) rw[i] = *(const u32x4*)(wg + (size_t)(64 * i) * ldw + k0);
  };
  auto GLOADNEXT = [&]() {
    const u16* ag2 = nA + (size_t)lr * nlda + lc * 8 + opq;
    const u16* wg2 = nW + (size_t)lr * nldw + lc * 8 + opq;
#pragma unroll
    for (int i = 0; i < 4; ++i) ra[i] = *(const u32x4*)(ag2 + (size_t)(64 * i) * nlda);
#pragma unroll
    for (int i = 0; i < NI; ++i) rw[i] = *(const u32x4*)(wg2 + (size_t)(64 * i) * nldw);
  };
  auto SSTORE = [&](int buf) {
#pragma unroll
    for (int i = 0; i < 4; ++i) *(u32x4*)(As + buf * A_ELEMS + (lr + 64 * i) * 64 + sw_st) = ra[i];
#pragma unroll
    for (int i = 0; i < NI; ++i) *(u32x4*)(Ws + buf * W_ELEMS + (lr + 64 * i) * 64 + sw_st) = rw[i];
  };
  const int swz = fr >> 1;
  const int off0 = ((0 + fq) ^ swz) * 8, off1 = ((4 + fq) ^ swz) * 8;
  const int KT = K >> 6;
  if (!pre) GLOAD(0);
  SSTORE(0);
  if (KT > 1) GLOAD(64);
  else if (nA) GLOADNEXT();
  __syncthreads();
#pragma unroll 1
  for (int kt = 0; kt < KT; ++kt) {
    const int buf = kt & 1;
    if (kt + 1 < KT) {
      SSTORE(buf ^ 1);
      if (kt + 2 < KT) GLOAD((kt + 2) * 64);
      else if (nA) GLOADNEXT();
    }
    const u16* as = As + buf * A_ELEMS + (wm * 64 + fr) * 64;
    const u16* ws = Ws + buf * W_ELEMS + (wn * 32 * NI + fr) * 64;
#pragma unroll
    for (int ks = 0; ks < 2; ++ks) {
      const int off = ks ? off1 : off0;
      bf16x8 wf[2 * NI], af[4];
#pragma unroll
      for (int nb = 0; nb < 2 * NI; ++nb) wf[nb] = *(const bf16x8*)(ws + nb * 16 * 64 + off);
#pragma unroll
      for (int mb = 0; mb < 4; ++mb) af[mb] = *(const bf16x8*)(as + mb * 16 * 64 + off);
#pragma unroll
      for (int nb = 0; nb < 2 * NI; ++nb)
#pragma unroll
        for (int mb = 0; mb < 4; ++mb) acc[nb][mb] = MFMA16(wf[nb], af[mb], acc[nb][mb]);
    }
    __syncthreads();
  }
}
template <int NI>
DI void gemm_core(f32x4 (&acc)[2 * NI][4], const u16* __restrict__ A, int lda, const u16* __restrict__ W, int ldw, int K, char* smem) {
  u32x4 ra[4], rw[NI];
  gemm_core<NI>(acc, A, lda, W, ldw, K, smem, ra, rw, false, nullptr, 0, nullptr, 0);
}

template <int NI>
DI void zero_acc(f32x4 (&acc)[2 * NI][4]) {
#pragma unroll
  for (int nb = 0; nb < 2 * NI; ++nb)
#pragma unroll
    for (int mb = 0; mb < 4; ++mb) acc[nb][mb] = f32x4{0.f, 0.f, 0.f, 0.f};
}

template <int NI, typename F>
DI void epilogue(f32x4 (&acc)[2 * NI][4], char* smem, F epi) {
  constexpr int SLD = 132;
  float* st = (float*)smem;
  const int tid = TIDX, lane = tid & 63, wave = tid >> 6;
  const int wm = wave >> 1, wn = wave & 1, fr = lane & 15, fq = lane >> 4;
#pragma unroll
  for (int q = 0; q < NI / 2; ++q) {
#pragma unroll
    for (int nn = 0; nn < 4; ++nn)
#pragma unroll
      for (int mb = 0; mb < 4; ++mb)
        *(f32x4*)(st + (wm * 64 + mb * 16 + fr) * SLD + wn * 64 + nn * 16 + fq * 4) = acc[4 * q + nn][mb];
    __syncthreads();
    for (int idx = tid; idx < 256 * 32; idx += NTHR) {
      const int row = idx >> 5, sc = (idx & 31) * 4;
      f32x4 v = *(const f32x4*)(st + row * SLD + sc);
      epi(row, (sc >> 6) * (32 * NI) + q * 64 + (sc & 63), v);
    }
    __syncthreads();
  }
}

DI bool next_tile(int k, int MT, int NT, int& mt, int& nt) {
  const int bid = BIDX, gd = GDIM;
  int tl = (gd == 256) ? k * 256 + (bid & 7) * 32 + (bid >> 3) : k * gd + bid;
  if (tl >= MT * NT) return false;
  const int band = tl / (MT * 8);
  const int w = (NT - band * 8) < 8 ? (NT - band * 8) : 8;
  const int within = tl - band * MT * 8;
  mt = within / w;
  nt = band * 8 + within % w;
  return true;
}

DI void lds_barrier() { asm volatile("s_waitcnt lgkmcnt(0)\n\ts_barrier" ::: "memory"); }

template <int NI, bool NT = false, typename F>
DI void epilogue_bf16(f32x4 (&acc)[2 * NI][4], char* smem, u16* dst, int ld, F tr) {
  constexpr int SLD = 264;
  u16* st = (u16*)smem;
  const int tid = TIDX, lane = tid & 63, wave = tid >> 6;
  const int wm = wave >> 1, wn = wave & 1, fr = lane & 15, fq = lane >> 4;
#pragma unroll
  for (int nb = 0; nb < 2 * NI; ++nb)
#pragma unroll
    for (int mb = 0; mb < 4; ++mb) {
      const int row = wm * 64 + mb * 16 + fr, col = wn * 32 * NI + nb * 16 + fq * 4;
      const f32x4 v = tr(row, col, acc[nb][mb]);
      uint2 o; o.x = pack2(v[0], v[1]); o.y = pack2(v[2], v[3]);
      *(uint2*)(st + row * SLD + col) = o;
    }
  lds_barrier();
  constexpr int CH = 8 * NI;
  for (int idx = tid; idx < 256 * CH; idx += NTHR) {
    const int row = idx / CH, ch = idx % CH;
    const u32x4 v = *(const u32x4*)(st + row * SLD + ch * 8);
    if (NT) __builtin_nontemporal_store(v, (u32x4*)(dst + (size_t)row * ld + ch * 8));
    else *(u32x4*)(dst + (size_t)row * ld + ch * 8) = v;
  }
  lds_barrier();
}

DI void store_bf4(u16* dst, f32x4 v) {
  uint2 o; o.x = pack2(v[0], v[1]); o.y = pack2(v[2], v[3]);
  *(uint2*)dst = o;
}

__device__ void rmsnorm_rows(const float* xin, const float* __restrict__ w, u16* xn, float* copy_to) {
  const int lane = TIDX & 63;
  const int gw = BIDX * NWV + (TIDX >> 6), nw = GDIM * NWV;
  for (int row = gw; row < M_TOK; row += nw) {
    const float* xr = xin + (size_t)row * DM;
    f32x4 v[4];
    float ss = 0.f;
#pragma unroll
    for (int i = 0; i < 4; ++i) {
      v[i] = *(const f32x4*)(xr + i * 256 + lane * 4);
      ss += v[i][0] * v[i][0] + v[i][1] * v[i][1] + v[i][2] * v[i][2] + v[i][3] * v[i][3];
    }
    ss = wave_sum(ss);
    const float rstd = rsqrtf(ss * (1.f / DM) + 1e-6f);
#pragma unroll
    for (int i = 0; i < 4; ++i) {
      const f32x4 ww = *(const f32x4*)(w + i * 256 + lane * 4);
      f32x4 o = {v[i][0] * rstd * ww[0], v[i][1] * rstd * ww[1], v[i][2] * rstd * ww[2], v[i][3] * rstd * ww[3]};
      if (xn) store_bf4(xn + (size_t)row * XLD + i * 256 + lane * 4, o);
      else *(f32x4*)(copy_to + (size_t)row * DM + i * 256 + lane * 4) = o;
      if (xn && copy_to) *(f32x4*)(copy_to + (size_t)row * DM + i * 256 + lane * 4) = v[i];
    }
  }
}

__device__ void phase_A(const Params& p, int l, char* smem) {
  const float* win = p.w_in + (size_t)l * DM * 7208;
  cvt_T(win, 1024, 7208, 0, 1824, p.WinT, XLD, 0, 0, smem);
  cvt_T(win, 1024, 7208, 1824, 1544, p.WinT, XLD, C_Z, 0, smem);
  cvt_T(win, 1024, 7208, 3368, 768, p.WinT, XLD, C_Q, 0, smem);
  if (l == 1) cvt_T(p.vres_down, 1024, 32, 0, 32, p.WinT, XLD, C_LV, 0, smem);
  cvt_T(win, 1024, 7208, 4136, 3072, p.WgT, XLD, 0, 0, smem);
  cvt_T(p.w_br_rw + (size_t)l * 512 * 1024, 512, 1024, 0, 1024, p.WbrT, 512, 0, 0, smem);
  cvt_T(p.w_br_ssm + (size_t)l * 512 * 1024, 512, 1024, 0, 1024, p.WbrT + 1024 * 512, 512, 0, 0, smem);
  cvt_T(p.w_br_att + (size_t)l * 512 * 1024, 512, 1024, 0, 1024, p.WbrT + 2 * 1024 * 512, 512, 0, 0, smem);
  cvt_T(p.w_out + (size_t)l * 1024 * 1024, 1024, 1024, 0, 1024, p.WoutT, XLD, 0, 0, smem);
  cvt_T(p.rw_w2 + (size_t)l * 64 * 512, 64, 512, 0, 512, p.w2T, 64, 0, 0, smem);
  cvt_T(p.rw_a2 + (size_t)l * 64 * 512, 64, 512, 0, 512, p.a2T, 64, 0, 0, smem);
  cvt_T(p.rw_g2 + (size_t)l * 160 * 512, 160, 512, 0, 512, p.g2T, 192, 0, 0, smem);
  if (l == 1) cvt_T(p.vres_v2, 32, 512, 0, 512, p.v2T, 64, 0, 0, smem);
  if (l == 0) rmsnorm_rows(p.x, p.norm_mix, p.XN, p.out);
  else rmsnorm_rows(p.out, p.norm_mix + DM, p.XN, nullptr);
}

__device__ void phase_G1(const Params& p, char* smem) {
  u32x4 ra[4], rw[4];
  bool pre = false;
  int mt, j;
  bool have = next_tile(0, 128, 17, mt, j);
  for (int k = 0; have; ++k) {
    int mt2 = 0, j2 = 0;
    const bool have2 = next_tile(k + 1, 128, 17, mt2, j2);
    const u16* A = p.XN + (size_t)mt * 256 * XLD;
    u16* dst = p.PROJ + (size_t)mt * 256 * PLD + j * 256;
    if (j < 16) {
      const bool nx = have2 && j2 < 16;
      f32x4 acc[8][4];
      zero_acc<4>(acc);
      gemm_core<4>(acc, A, XLD, p.WinT + (size_t)j * 256 * XLD, XLD, DM, smem, ra, rw, pre,
                   nx ? p.XN + (size_t)mt2 * 256 * XLD : nullptr, XLD, p.WinT + (size_t)j2 * 256 * XLD, XLD);
      pre = nx;
      epilogue_bf16<4, true>(acc, smem, dst, PLD, [&](int, int, f32x4 v) { return v; });
    } else {
      f32x4 acc[4][4];
      zero_acc<2>(acc);
      gemm_core<2>(acc, A, XLD, p.WinT + (size_t)j * 256 * XLD, XLD, DM, smem);
      pre = false;
      epilogue_bf16<2, true>(acc, smem, dst, PLD, [&](int, int, f32x4 v) { return v; });
    }
    mt = mt2; j = j2; have = have2;
  }
}

__device__ void phase_pre(const Params& p, int l) {
  const int lane = TIDX & 63;
  const int gw = BIDX * NWV + (TIDX >> 6), nw = GDIM * NWV;
  const float* mu = p.rw_mu + l * 1824;
  for (int row = gw; row < M_TOK; row += nw) {
    const bool hp = (row & (SEQ - 1)) != 0;
    const u16* pr = p.PROJ + (size_t)row * PLD;
    const u16* pp = pr - PLD;
    u16* la = p.LA + (size_t)row * LALD;
    auto mix = [&](int colp, float m) {
      const float a = bf2f(pr[colp]);
      const float b = hp ? bf2f(pp[colp]) : 0.f;
      return a + (b - a) * m;
    };
    la[lane] = f2bf(tanhf_(mix(C_LW + lane, mu[C_LW + lane])));
    la[64 + lane] = f2bf(mix(C_LA + lane, mu[C_LA + lane]));
    la[128 + lane] = f2bf(sigmoidf_(mix(C_LG + lane, mu[C_LG + lane])));
    la[192 + lane] = f2bf(sigmoidf_(mix(C_LG + 64 + lane, mu[C_LG + 64 + lane])));
    u16 e4 = 0;
    if (lane < 32) e4 = f2bf(sigmoidf_(mix(C_LG + 128 + lane, mu[C_LG + 128 + lane])));
    la[256 + lane] = e4;
    u16 e5 = 0;
    if (l == 1 && lane < 32) e5 = f2bf(mix(C_LV + lane, p.vres_mu[lane]));
    la[320 + lane] = e5;
    if (l == 0) {
#pragma unroll
      for (int j = 0; j < 8; ++j) {
        const int c = lane + 64 * j;
        p.VF[(size_t)row * 512 + c] = f2bf(mix(C_V + c, mu[C_V + c]));
      }
    }
  }
}

__device__ void phase_prep(const Params& p, int l, char* smem) {
  const int nk = (l == 1) ? 4 : 3;
  for (int k = 0;; ++k) {
    int mt, kn;
    if (!next_tile(k, 128, 2 * nk, mt, kn)) break;
    const int kind = kn >> 1, nt = kn & 1;
    const int koff = kind == 0 ? 0 : (kind == 1 ? 64 : (kind == 2 ? 128 : 320));
    const int Kk = kind == 2 ? 192 : 64;
    const u16* Wk = kind == 0 ? p.w2T : (kind == 1 ? p.a2T : (kind == 2 ? p.g2T : p.v2T));
    f32x4 acc[8][4];
    zero_acc<4>(acc);
    gemm_core<4>(acc, p.LA + (size_t)mt * 256 * LALD + koff, LALD, Wk + (size_t)nt * 256 * Kk, Kk, Kk, smem);
    const int m0 = mt * 256, n0 = nt * 256;
    if (kind == 0) {
      const float* w0 = p.rw_w0 + l * 512 + n0;
      epilogue_bf16<4>(acc, smem, p.WR + (size_t)m0 * 512 + n0, 512, [&](int, int col, f32x4 v) {
        const f32x4 b = *(const f32x4*)(w0 + col);
        f32x4 o = {v[0] + b[0], v[1] + b[1], v[2] + b[2], v[3] + b[3]};
        return o;
      });
    } else if (kind == 1) {
      const float* a0 = p.rw_a0 + l * 512 + n0;
      epilogue_bf16<4>(acc, smem, p.AA + (size_t)m0 * 512 + n0, 512, [&](int, int col, f32x4 v) {
        const f32x4 b = *(const f32x4*)(a0 + col);
        f32x4 o = {sigmoidf_(v[0] + b[0]), sigmoidf_(v[1] + b[1]), sigmoidf_(v[2] + b[2]), sigmoidf_(v[3] + b[3])};
        return o;
      });
    } else if (kind == 2) {
      epilogue_bf16<4>(acc, smem, p.GG + (size_t)m0 * 512 + n0, 512, [&](int, int, f32x4 v) { return v; });
    } else {
      const float* v0 = p.vres_v0 + n0;
      const float* mu = p.rw_mu + l * 1824 + C_V + n0;
      epilogue<4>(acc, smem, [&](int row, int col, f32x4 v) {
        const int m = m0 + row;
        const bool hp = (m & (SEQ - 1)) != 0;
        const u16* pr = p.PROJ + (size_t)m * PLD + C_V + n0 + col;
        u16* vf = p.VF + (size_t)m * 512 + n0 + col;
        f32x4 o;
#pragma unroll
        for (int j = 0; j < 4; ++j) {
          const float a = bf2f(pr[j]);
          const float b = hp ? bf2f(pr[j - PLD]) : 0.f;
          const float vv = a + (b - a) * mu[col + j];
          const float gate = sigmoidf_(v0[col + j] + v[j]);
          const float f = bf2f(vf[j]);
          o[j] = vv + (f - vv) * gate;
        }
        store_bf4(vf, o);
      });
    }
  }
}

__device__ void rwkv_item(const Params& p, int l, int item, char* smem, int dry) {
  const int b = item >> 3, hh = item & 7;
  const int tid = TIDX, lane = tid & 63, wave = tid >> 6;
  float* stg = (float*)smem;
  float* ybuf = stg + 2 * 16 * 448;
  float* bon = ybuf + 16 * 64;
  const int col = hh * 64 + lane;
  const float mu_r = p.rw_mu[l * 1824 + C_R + col], mu_k = p.rw_mu[l * 1824 + C_K + col];
  const float kk_w = p.rw_k_k[l * 512 + col], ka_w = p.rw_k_a[l * 512 + col], rk_w = p.rw_r_k[l * 512 + col];
  const float gnw = p.rw_gn_w[l * 512 + col], gnb = p.rw_gn_b[l * 512 + col];
  const size_t row0 = (size_t)b * SEQ;
  const int r0 = wave * 8 + (lane >> 4) * 2, c = lane & 15;
  f32x2 Sa[2], Sb[2];
#pragma unroll
  for (int i = 0; i < 2; ++i) { Sa[i] = f32x2{0.f, 0.f}; Sb[i] = f32x2{0.f, 0.f}; }
  u16 q_rt[2], q_rp[2], q_kt[2], q_kp[2], q_v[2], q_a[2], q_w[2], q_g[2];
#define RW_LOAD(t0)                                                                                 \
  {                                                                                                 \
    int pin_ = 1;                                                                                   \
    asm volatile("" : "+s"(pin_));                                                                  \
    _Pragma("unroll") for (int i = 0; i < 2; ++i) {                                                 \
      q_rt[i] = 0; q_kt[i] = 0; q_rp[i] = 0; q_kp[i] = 0; q_v[i] = 0; q_a[i] = 0; q_w[i] = 0; q_g[i] = 0; \
    }                                                                                               \
    if (pin_) {                                                                                     \
    _Pragma("unroll") for (int i = 0; i < 2; ++i) {                                                 \
      const int t = (t0) + wave + 8 * i;                                                            \
      const size_t row = row0 + t;                                                                  \
      const u16* pr = p.PROJ + row * PLD;                                                           \
      q_rt[i] = pr[C_R + col]; q_kt[i] = pr[C_K + col];                                             \
      q_rp[i] = t > 0 ? pr[C_R + col - PLD] : (u16)0; q_kp[i] = t > 0 ? pr[C_K + col - PLD] : (u16)0; \
      q_v[i] = p.VF[row * 512 + col]; q_a[i] = p.AA[row * 512 + col];                               \
      q_w[i] = p.WR[row * 512 + col]; q_g[i] = p.GG[row * 512 + col];                               \
    }                                                                                               \
    }                                                                                               \
  }
#define RW_FILL(buf)                                                                                \
  {                                                                                                 \
    _Pragma("unroll") for (int i = 0; i < 2; ++i) {                                                 \
      const int tt = wave + 8 * i;                                                                  \
      const float rt = bf2f(q_rt[i]), kt_ = bf2f(q_kt[i]);                                          \
      const float r = rt + (bf2f(q_rp[i]) - rt) * mu_r;                                             \
      const float kx = kt_ + (bf2f(q_kp[i]) - kt_) * mu_k;                                          \
      const float aa = bf2f(q_a[i]);                                                                \
      const float kkv = kx * kk_w;                                                                  \
      const float nrm = sqrtf(wave_sum(kkv * kkv));                                                 \
      const float kkn = kkv / fmaxf(nrm, 1e-12f);                                                   \
      const float knew = kx * (1.f + (aa - 1.f) * ka_w);                                            \
      const float wl = -softplusf_(-bf2f(q_w[i])) - 0.5f;                                           \
      const float wdec = __expf(-__expf(wl));                                                       \
      float* s = stg + ((buf) * 16 + tt) * 448;                                                     \
      s[lane] = r; s[64 + lane] = wdec; s[128 + lane] = knew; s[192 + lane] = -kkn;                 \
      s[256 + lane] = kkn * aa; s[320 + lane] = bf2f(q_v[i]); s[384 + lane] = bf2f(q_g[i]);         \
      const float bs = wave_sum(r * knew * rk_w);                                                   \
      if (lane == 0) bon[(buf) * 16 + tt] = bs;                                                     \
    }                                                                                               \
  }
  __syncthreads();
  RW_LOAD(0);
  RW_FILL(0);
  __syncthreads();
  for (int ch = 0; ch < SEQ / 16; ++ch) {
    const int buf = ch & 1, t0 = ch * 16;
    {
    if (ch + 1 < SEQ / 16) RW_LOAD(t0 + 16);
    {
      f32x4 op[2][5];
      f32x2 ov[2];
      const float* sb = stg + buf * 16 * 448 + c * 4;
#define RW_LDOPS(tt, q)                                                        \
      {                                                                        \
        const float* s_ = sb + (tt) * 448;                                     \
        _Pragma("unroll") for (int u = 0; u < 5; ++u) op[q][u] = *(const f32x4*)(s_ + 64 * u); \
        ov[q] = *(const f32x2*)(stg + (buf * 16 + (tt)) * 448 + 320 + r0);     \
      }
#define PK_LO(v) __builtin_shufflevector((v), (v), 0, 1)
#define PK_HI(v) __builtin_shufflevector((v), (v), 2, 3)
      RW_LDOPS(0, 0);
#pragma unroll 1
      for (int t2 = 0; t2 < 16; t2 += 2) {
#pragma unroll
      for (int q = 0; q < 2; ++q) {
        const int tt = t2 + q;
        if (q == 0) RW_LDOPS(tt + 1, 1) else if (t2 + 2 < 16) RW_LDOPS(tt + 1, 0);
        f32x2 sA = Sa[0] * PK_LO(op[q][3]); sA += Sa[1] * PK_HI(op[q][3]);
        f32x2 sB = Sb[0] * PK_LO(op[q][3]); sB += Sb[1] * PK_HI(op[q][3]);
        const float saa = red16(sA[0] + sA[1]);
        const float sab = red16(sB[0] + sB[1]);
        const f32x2 saa2 = {saa, saa}, sab2 = {sab, sab};
        const f32x2 va2 = {ov[q][0], ov[q][0]}, vb2 = {ov[q][1], ov[q][1]};
        Sa[0] = Sa[0] * PK_LO(op[q][1]) + saa2 * PK_LO(op[q][4]) + va2 * PK_LO(op[q][2]);
        Sa[1] = Sa[1] * PK_HI(op[q][1]) + saa2 * PK_HI(op[q][4]) + va2 * PK_HI(op[q][2]);
        Sb[0] = Sb[0] * PK_LO(op[q][1]) + sab2 * PK_LO(op[q][4]) + vb2 * PK_LO(op[q][2]);
        Sb[1] = Sb[1] * PK_HI(op[q][1]) + sab2 * PK_HI(op[q][4]) + vb2 * PK_HI(op[q][2]);
        f32x2 yA = Sa[0] * PK_LO(op[q][0]); yA += Sa[1] * PK_HI(op[q][0]);
        f32x2 yB = Sb[0] * PK_LO(op[q][0]); yB += Sb[1] * PK_HI(op[q][0]);
        const float ya = red16(yA[0] + yA[1]);
        const float yb = red16(yB[0] + yB[1]);
        if (c == 0) { f32x2 yy = {ya, yb}; *(f32x2*)(ybuf + tt * 64 + r0) = yy; }
      }
      }
#undef RW_LDOPS
    }
    }
    __syncthreads();
    {
#pragma unroll
    for (int i = 0; i < 2; ++i) {
      const int tt = wave + 8 * i;
      const float y = ybuf[tt * 64 + lane];
      const float mean = wave_sum(y) * (1.f / 64.f);
      const float d = y - mean;
      const float var = wave_sum(d * d) * (1.f / 64.f);
      const float yn = d * rsqrtf(var + 64e-5f) * gnw + gnb;
      const float* s = stg + (buf * 16 + tt) * 448;
      const float o = (yn + bon[buf * 16 + tt] * s[320 + lane]) * s[384 + lane];
      if (!dry) p.GG[(row0 + t0 + tt) * 512 + col] = f2bf(o);
    }
    if (ch + 1 < SEQ / 16) RW_FILL(buf ^ 1);
    }
    __syncthreads();
  }
#undef RW_LOAD
#undef RW_FILL
}

__device__ void ssd_item(const Params& p, int l, int item, char* smem, int dry) {
  const int b = item >> 3, hh = item & 7, g = hh >> 2;
  const int tid = TIDX, lane = tid & 63, wave = tid >> 6;
  constexpr int SS = 456;
  float* stg = (float*)smem;
  float* ybuf = stg + 2 * 16 * SS;
  int chn[5] = {hh * 64 + lane, 512 + g * 128 + lane, 512 + g * 128 + 64 + lane, 768 + g * 128 + lane, 768 + g * 128 + 64 + lane};
  float cw[4][5], cbv[5];
#pragma unroll
  for (int k = 0; k < 5; ++k) {
    cbv[k] = p.conv_b[l * 1024 + chn[k]];
#pragma unroll
    for (int j = 0; j < 4; ++j) cw[j][k] = p.conv_w[(l * 4 + j) * 1024 + chn[k]];
  }
  const float dtb = p.dt_bias[l * 8 + hh];
  const float Aneg = -__expf(p.a_log[l * 8 + hh]);
  const float Dsk = p.ssm_d[l * 8 + hh];
  const size_t row0 = (size_t)b * SEQ;
  const int r0 = wave * 8 + (lane >> 4) * 2, c = lane & 15;
  f32x2 Sa[4], Sb[4];
#pragma unroll
  for (int i = 0; i < 4; ++i) { Sa[i] = f32x2{0.f, 0.f}; Sb[i] = f32x2{0.f, 0.f}; }
  u16 q_x[5][5], q_z[2], q_dt[2];
#define SSD_LOAD(t0)                                                                   \
  {                                                                                    \
    _Pragma("unroll") for (int k = 0; k < 5; ++k) {                                    \
      const int t = (t0) + 2 * wave - 3 + k;                                           \
      const u16* pr = p.PROJ + (row0 + (t < 0 ? 0 : t)) * PLD + C_XBC;                 \
      _Pragma("unroll") for (int j = 0; j < 5; ++j) q_x[k][j] = t >= 0 ? pr[chn[j]] : (u16)0; \
    }                                                                                  \
    int pin_ = 1;                                                                      \
    asm volatile("" : "+s"(pin_));                                                     \
    q_z[0] = 0; q_z[1] = 0; q_dt[0] = 0; q_dt[1] = 0;                                  \
    if (pin_) {                                                                        \
    _Pragma("unroll") for (int i = 0; i < 2; ++i) {                                    \
      const u16* pr = p.PROJ + (row0 + (t0) + 2 * wave + i) * PLD;                     \
      q_z[i] = pr[C_Z + hh * 64 + lane]; q_dt[i] = pr[C_DT + hh];                      \
    }                                                                                  \
    }                                                                                  \
  }
#define SSD_FILL(buf)                                                                  \
  {                                                                                    \
    _Pragma("unroll") for (int i = 0; i < 2; ++i) {                                    \
      float cv[5];                                                                     \
      _Pragma("unroll") for (int j = 0; j < 5; ++j) {                                  \
        float a = cbv[j];                                                              \
        _Pragma("unroll") for (int k = 0; k < 4; ++k) a += cw[k][j] * bf2f(q_x[i + k][j]); \
        cv[j] = siluf_(a);                                                             \
      }                                                                                \
      const float dt = softplusf_(bf2f(q_dt[i]) + dtb);                                \
      float* s = stg + ((buf) * 16 + 2 * wave + i) * SS;                               \
      s[lane] = cv[1]; s[64 + lane] = cv[2]; s[128 + lane] = cv[3]; s[192 + lane] = cv[4]; \
      s[256 + lane] = cv[0] * dt; s[320 + lane] = cv[0]; s[384 + lane] = bf2f(q_z[i]); \
      if (lane == 0) s[448] = __expf(dt * Aneg);                                       \
    }                                                                                  \
  }
  __syncthreads();
  SSD_LOAD(0);
  SSD_FILL(0);
  __syncthreads();
  for (int ch = 0; ch < SEQ / 16; ++ch) {
    const int buf = ch & 1, t0 = ch * 16;
    {
    if (ch + 1 < SEQ / 16) SSD_LOAD(t0 + 16);
    {
      f32x4 op[2][4];
      f32x2 oxd[2];
      float oda[2];
      const float* sb = stg + buf * 16 * SS;
#define SSD_LDOPS(tt, q)                                                       \
      {                                                                        \
        const float* s_ = sb + (tt) * SS;                                      \
        op[q][0] = *(const f32x4*)(s_ + c * 8);                                \
        op[q][1] = *(const f32x4*)(s_ + c * 8 + 4);                            \
        op[q][2] = *(const f32x4*)(s_ + 128 + c * 8);                          \
        op[q][3] = *(const f32x4*)(s_ + 128 + c * 8 + 4);                      \
        oxd[q] = *(const f32x2*)(s_ + 256 + r0);                               \
        oda[q] = s_[448];                                                      \
      }
      SSD_LDOPS(0, 0);
#pragma unroll 1
      for (int t2 = 0; t2 < 16; t2 += 2) {
#pragma unroll
      for (int q = 0; q < 2; ++q) {
        const int tt = t2 + q;
        if (q == 0) SSD_LDOPS(tt + 1, 1) else if (t2 + 2 < 16) SSD_LDOPS(tt + 1, 0);
        const f32x2 dA2 = {oda[q], oda[q]};
        const f32x2 xa2 = {oxd[q][0], oxd[q][0]}, xb2 = {oxd[q][1], oxd[q][1]};
        const f32x2 B2[4] = {PK_LO(op[q][0]), PK_HI(op[q][0]), PK_LO(op[q][1]), PK_HI(op[q][1])};
        const f32x2 C2[4] = {PK_LO(op[q][2]), PK_HI(op[q][2]), PK_LO(op[q][3]), PK_HI(op[q][3])};
        f32x2 yA = {0.f, 0.f}, yB = {0.f, 0.f};
#pragma unroll
        for (int j = 0; j < 4; ++j) {
          Sa[j] = Sa[j] * dA2 + xa2 * B2[j];
          Sb[j] = Sb[j] * dA2 + xb2 * B2[j];
          yA += Sa[j] * C2[j];
          yB += Sb[j] * C2[j];
        }
        const float ya = red16(yA[0] + yA[1]);
        const float yb = red16(yB[0] + yB[1]);
        if (c == 0) { f32x2 yy = {ya, yb}; *(f32x2*)(ybuf + tt * 64 + r0) = yy; }
      }
      }
#undef SSD_LDOPS
    }
    }
    __syncthreads();
    {
#pragma unroll
    for (int i = 0; i < 2; ++i) {
      const int tt = wave + 8 * i;
      const float* s = stg + (buf * 16 + tt) * SS;
      const float y = ybuf[tt * 64 + lane] + Dsk * s[320 + lane];
      const float zz = s[384 + lane];
      if (!dry) p.PROJ[(row0 + t0 + tt) * PLD + C_Z + hh * 64 + lane] = f2bf(y * siluf_(zz));
    }
    if (ch + 1 < SEQ / 16) SSD_FILL(buf ^ 1);
    }
    __syncthreads();
  }
#undef SSD_LOAD
#undef SSD_FILL
}

__device__ void attn_item(const Params& p, int l, int item, char* smem, int dry) {
  const int hp = item & 3, qb = (item >> 2) & 15, b = item >> 6;
  const int kvh = hp >> 1;
  u16* Ks = (u16*)smem;
  u16* Vt = (u16*)(smem + 256 * 72 * 2);
  float* invd = (float*)(smem + 256 * 72 * 2 + 64 * 264 * 2);
  const int tid = TIDX, lane = tid & 63, wave = tid >> 6, wq = wave & 3, l31 = lane & 31, h = lane >> 5;
  const int hq = hp * 2 + (wave >> 2);
  const size_t rowq0 = (size_t)b * SEQ + qb * 128;
  const long rowk0 = (long)rowq0 - 128;
  __syncthreads();
#pragma unroll
  for (int i = 0; i < 4; ++i) {
    const int cidx = tid + NTHR * i;
    const int key = cidx >> 3, cc = cidx & 7;
    uint4 v = {0u, 0u, 0u, 0u};
    if (qb > 0 || key >= 128) v = *(const uint4*)(p.PROJ + (size_t)(rowk0 + key) * PLD + C_AK + kvh * 64 + cc * 8);
    *(uint4*)(Ks + key * 72 + cc * 8) = v;
  }
#pragma unroll
  for (int i = 0; i < 4; ++i) {
    const int key = (tid & 63) + 64 * i;
    const int dc = tid >> 6;
    uint4 v = {0u, 0u, 0u, 0u};
    if (qb > 0 || key >= 128) v = *(const uint4*)(p.PROJ + (size_t)(rowk0 + key) * PLD + C_AV + kvh * 64 + dc * 8);
    const unsigned e[4] = {v.x, v.y, v.z, v.w};
#pragma unroll
    for (int j = 0; j < 4; ++j) {
      Vt[(dc * 8 + 2 * j) * 264 + key] = (u16)(e[j] & 0xffffu);
      Vt[(dc * 8 + 2 * j + 1) * 264 + key] = (u16)(e[j] >> 16);
    }
  }
  __syncthreads();
  const u16* qptr = p.PROJ + (rowq0 + wq * 32 + l31) * PLD + C_Q + hq * 64 + h * 8;
  bf16x8 qf[4];
#pragma unroll
  for (int ks = 0; ks < 4; ++ks) qf[ks] = *(const bf16x8*)(qptr + ks * 16);
  f32x16 sc[5];
#pragma unroll
  for (int i = 0; i < 5; ++i) {
#pragma unroll
    for (int r = 0; r < 16; ++r) sc[i][r] = 0.f;
    const u16* kp = Ks + ((wq + i) * 32 + l31) * 72 + h * 8;
#pragma unroll
    for (int ks = 0; ks < 4; ++ks) {
      const bf16x8 kf = *(const bf16x8*)(kp + ks * 16);
      sc[i] = MFMA(kf, qf[ks], sc[i]);
    }
  }
  const int qi = wq * 32 + l31;
  const float sink = p.sinks[l * 8 + hq];
  float m = sink;
#pragma unroll
  for (int i = 0; i < 5; ++i)
#pragma unroll
    for (int r = 0; r < 16; ++r) {
      const int j = (wq + i) * 32 + crow(r, h);
      const int rel = qi + 128 - j;
      const bool valid = (rel >= 0) && (rel < 128) && (qb > 0 || j >= 128);
      const float s = valid ? sc[i][r] * 0.125f : -INFINITY;
      sc[i][r] = s;
      m = fmaxf(m, s);
    }
  m = fmaxf(m, __shfl_xor(m, 32));
  float sum = 0.f;
#pragma unroll
  for (int i = 0; i < 5; ++i)
#pragma unroll
    for (int r = 0; r < 16; ++r) {
      const float pv = __expf(sc[i][r] - m);
      sc[i][r] = pv;
      sum += pv;
    }
  sum += __shfl_xor(sum, 32);
  const float denom = sum + __expf(sink - m);
  if (h == 0) invd[(wave >> 2) * 128 + qi] = 1.f / denom;
  f32x16 o[2];
#pragma unroll
  for (int db = 0; db < 2; ++db)
#pragma unroll
    for (int r = 0; r < 16; ++r) o[db][r] = 0.f;
#pragma unroll
  for (int i = 0; i < 5; ++i)
#pragma unroll
    for (int s2 = 0; s2 < 2; ++s2) {
      bf16x8 pa;
#pragma unroll
      for (int j = 0; j < 8; ++j) pa[j] = (short)f2bf(sc[i][8 * s2 + j]);
#pragma unroll
      for (int db = 0; db < 2; ++db) {
        const u16* vp = Vt + (db * 32 + l31) * 264 + (wq + i) * 32 + 16 * s2 + 4 * h;
        const s16x4 lo = *(const s16x4*)vp;
        const s16x4 hi = *(const s16x4*)(vp + 8);
        const bf16x8 vf = __builtin_shufflevector(lo, hi, 0, 1, 2, 3, 4, 5, 6, 7);
        o[db] = MFMA(pa, vf, o[db]);
      }
    }
  __syncthreads();
#pragma unroll
  for (int db = 0; db < 2; ++db)
#pragma unroll
    for (int r = 0; r < 16; ++r) {
      const int q = wq * 32 + crow(r, h);
      if (!dry) p.PROJ[(rowq0 + q) * PLD + C_Q + hq * 64 + db * 32 + l31] = f2bf(o[db][r] * invd[(wave >> 2) * 128 + q]);
    }
}

__device__ void phase_attn(const Params& p, int l, char* smem, int dry) {
  for (int it = BIDX; it < 1024; it += GDIM) attn_item(p, l, it, smem, dry);
}
__device__ void phase_mix(const Params& p, int l, char* smem, int dry) {
  for (int it = BIDX; it < 256; it += GDIM) {
    if (it < 128) rwkv_item(p, l, it, smem, dry);
    else ssd_item(p, l, it - 128, smem, dry);
  }
}

__device__ void phase_post(const Params& p, int l, char* smem) {
  cvt_T(p.w_gu + (size_t)l * DM * 2 * FH, 1024, 2 * FH, 0, 2 * FH, p.WguT, XLD, 0, 1, smem);
  cvt_T(p.w_down + (size_t)l * FH * DM, FH, 1024, 0, 1024, p.WdownT, FH, 0, 0, smem);
  const int lane = TIDX & 63;
  const int gw = BIDX * NWV + (TIDX >> 6), nw = GDIM * NWV;
  const float* nwp = p.ssm_norm_w + l * 512 + lane * 8;
  for (int row = gw; row < M_TOK; row += nw) {
    u16* pz = p.PROJ + (size_t)row * PLD + C_Z + lane * 8;
    const uint4 raw = *(const uint4*)pz;
    const unsigned e[4] = {raw.x, raw.y, raw.z, raw.w};
    float v[8];
    float ss = 0.f;
#pragma unroll
    for (int j = 0; j < 4; ++j) {
      v[2 * j] = bf2f((u16)(e[j] & 0xffffu));
      v[2 * j + 1] = bf2f((u16)(e[j] >> 16));
      ss += v[2 * j] * v[2 * j] + v[2 * j + 1] * v[2 * j + 1];
    }
#pragma unroll
    for (int o = 16; o > 0; o >>= 1) ss += __shfl_xor(ss, o);
    const float rstd = rsqrtf(ss * (1.f / 256.f) + 1e-6f);
    uint4 ov;
    ov.x = pack2(v[0] * rstd * nwp[0], v[1] * rstd * nwp[1]);
    ov.y = pack2(v[2] * rstd * nwp[2], v[3] * rstd * nwp[3]);
    ov.z = pack2(v[4] * rstd * nwp[4], v[5] * rstd * nwp[5]);
    ov.w = pack2(v[6] * rstd * nwp[6], v[7] * rstd * nwp[7]);
    *(uint4*)pz = ov;
  }
}

__device__ void phase_G2(const Params& p, int l, char* smem) {
  const int lane = TIDX & 63, wave = TIDX >> 6, wn = wave & 1, fq = lane >> 4;
  u32x4 ra[4], rw[2];
  bool pre = false;
  int mt, nt;
  bool have = next_tile(0, 128, 8, mt, nt);
  for (int k = 0; have; ++k) {
    int mt2 = 0, nt2 = 0;
    const bool have2 = next_tile(k + 1, 128, 8, mt2, nt2);
    const int m0 = mt * 256, n0 = nt * 128;
    f32x4 tot[4][4];
    zero_acc<2>(tot);
#pragma unroll 1
    for (int br = 0; br < 3; ++br) {
      const u16* Ab; int lda;
      if (br == 0) { Ab = p.GG + (size_t)m0 * 512; lda = 512; }
      else if (br == 1) { Ab = p.PROJ + (size_t)m0 * PLD + C_Z; lda = PLD; }
      else { Ab = p.PROJ + (size_t)m0 * PLD + C_Q; lda = PLD; }
      const u16* Wb = p.WbrT + ((size_t)br * 1024 + n0) * 512;
      f32x4 ac[4][4];
      zero_acc<2>(ac);
      gemm_core<2>(ac, p.XN + (size_t)m0 * XLD, XLD, p.WgT + ((size_t)br * 1024 + n0) * XLD, XLD, DM, smem, ra, rw, pre,
                   Ab, lda, Wb, 512);
      unsigned sg[4][4][2];
      const float* gb = p.gate_b + l * 3072 + br * 1024 + n0 + wn * 64 + fq * 4;
#pragma unroll
      for (int nb = 0; nb < 4; ++nb) {
        const f32x4 bias = *(const f32x4*)(gb + nb * 16);
#pragma unroll
        for (int mb = 0; mb < 4; ++mb) {
          sg[nb][mb][0] = cvt_pk_bf16(sigmoidf_(ac[nb][mb][0] + bias[0]), sigmoidf_(ac[nb][mb][1] + bias[1]));
          sg[nb][mb][1] = cvt_pk_bf16(sigmoidf_(ac[nb][mb][2] + bias[2]), sigmoidf_(ac[nb][mb][3] + bias[3]));
        }
      }
      zero_acc<2>(ac);
      const bool more = br < 2 || have2;
      const int m0n = br < 2 ? m0 : mt2 * 256, n0n = br < 2 ? n0 : nt2 * 128, brn = br < 2 ? br + 1 : 0;
      gemm_core<2>(ac, Ab, lda, Wb, 512, 512, smem, ra, rw, true,
                   more ? p.XN + (size_t)m0n * XLD : nullptr, XLD, p.WgT + ((size_t)brn * 1024 + n0n) * XLD, XLD);
      pre = more;
#pragma unroll
      for (int nb = 0; nb < 4; ++nb)
#pragma unroll
        for (int mb = 0; mb < 4; ++mb) {
          tot[nb][mb][0] += __uint_as_float(sg[nb][mb][0] << 16) * ac[nb][mb][0];
          tot[nb][mb][1] += __uint_as_float(sg[nb][mb][0] & 0xffff0000u) * ac[nb][mb][1];
          tot[nb][mb][2] += __uint_as_float(sg[nb][mb][1] << 16) * ac[nb][mb][2];
          tot[nb][mb][3] += __uint_as_float(sg[nb][mb][1] & 0xffff0000u) * ac[nb][mb][3];
        }
    }
    u16* dst = p.MERGED + (size_t)m0 * DM + n0;
    epilogue_bf16<2>(tot, smem, dst, DM, [&](int, int, f32x4 v) { return v; });
    mt = mt2; nt = nt2; have = have2;
  }
}

__device__ void phase_resid(const Params& p, const u16* A, int K, const u16* W, int ldw, char* smem, int dry) {
  for (int k = 0;; ++k) {
    int mt, nt;
    if (!next_tile(k, 128, 4, mt, nt)) break;
    f32x4 acc[8][4];
    zero_acc<4>(acc);
    gemm_core<4>(acc, A + (size_t)mt * 256 * K, K, W + (size_t)nt * 256 * ldw, ldw, K, smem);
    float* dst = p.out + (size_t)mt * 256 * DM + nt * 256;
    epilogue<4>(acc, smem, [&](int row, int col, f32x4 v) {
      f32x4* px = (f32x4*)(dst + (size_t)row * DM + col);
      f32x4 x = *px;
      x[0] += v[0]; x[1] += v[1]; x[2] += v[2]; x[3] += v[3];
      if (!dry) *px = x;
    });
  }
}

__device__ void phase_G4(const Params& p, char* smem) {
  u32x4 ra[4], rw[4];
  bool pre = false;
  int mt, nt;
  bool have = next_tile(0, 128, 22, mt, nt);
  for (int k = 0; have; ++k) {
    int mt2 = 0, nt2 = 0;
    const bool have2 = next_tile(k + 1, 128, 22, mt2, nt2);
    f32x4 acc[8][4];
    zero_acc<4>(acc);
    gemm_core<4>(acc, p.XN + (size_t)mt * 256 * XLD, XLD, p.WguT + (size_t)nt * 256 * XLD, XLD, DM, smem, ra, rw, pre,
                 have2 ? p.XN + (size_t)mt2 * 256 * XLD : nullptr, XLD, p.WguT + (size_t)nt2 * 256 * XLD, XLD);
    pre = have2;
    f32x4 hv[4][4];
#pragma unroll
    for (int pb = 0; pb < 4; ++pb) {
      const int nbg = (pb >> 1) * 4 + (pb & 1);
#pragma unroll
      for (int mb = 0; mb < 4; ++mb)
#pragma unroll
        for (int j = 0; j < 4; ++j) hv[pb][mb][j] = siluf_(acc[nbg][mb][j]) * acc[nbg + 2][mb][j];
    }
    u16* dst = p.H + (size_t)mt * 256 * FH + nt * 128;
    epilogue_bf16<2>(hv, smem, dst, FH, [&](int, int, f32x4 v) { return v; });
    mt = mt2; nt = nt2; have = have2;
  }
}

__device__ void phase_final(const Params& p) { rmsnorm_rows(p.out, p.norm_final, nullptr, p.out); }

DI void grid_barrier(unsigned* bar, unsigned target) {
  __syncthreads();
  if (TIDX == 0) {
    __threadfence();
    __hip_atomic_fetch_add(bar, 1u, __ATOMIC_RELAXED, __HIP_MEMORY_SCOPE_AGENT);
    while (__hip_atomic_load(bar, __ATOMIC_RELAXED, __HIP_MEMORY_SCOPE_AGENT) < target) __builtin_amdgcn_s_sleep(4);
    __threadfence();
  }
  __syncthreads();
}

#define XB_TMO      128
#define XB_XCNT(j)  (256  + 64 * (j))
#define XB_XSUB(j)  (1280 + 64 * (j))
#define XB_XGEN(j)  (2304 + 64 * (j))
#define XB_TOP      3328
#define XB_TOPGEN   3392
#define XCD_BAR_WORDS 3456
#define XB_SPIN_CAP (1u << 20)
#define LAS __attribute__((address_space(3)))
DI unsigned xb_ld(unsigned* p) { return __hip_atomic_load(p, __ATOMIC_RELAXED, __HIP_MEMORY_SCOPE_AGENT); }
DI unsigned xb_add(unsigned* p, unsigned v) { return __hip_atomic_fetch_add(p, v, __ATOMIC_RELAXED, __HIP_MEMORY_SCOPE_AGENT); }
DI unsigned xb_xcc_id() { return (unsigned)__builtin_amdgcn_s_getreg((3 << 11) | 20) & 0xFu; }
#define XB_SPIN(cond, bar) do { unsigned _sp = 0; while (cond) { __builtin_amdgcn_s_sleep(1); \
    if ((++_sp & 255u) == 0u) { if (xb_ld(&(bar)[XB_TMO])) break; if (_sp > XB_SPIN_CAP) { atomicAdd(&(bar)[XB_TMO], 1u); break; } } } } while (0)
DI void xcd_barrier_post(unsigned* bar) {
  if (threadIdx.x == 0) (void)xb_add(&bar[XB_XCNT(xb_xcc_id())], 1u);
}
DI void xcd_barrier_complete(unsigned* bar, unsigned x, unsigned& nloc, unsigned& nx) {
  const unsigned G = gridDim.x;
  unsigned sum, cnt, mine, sp = 0u;
  for (;;) {
    sum = 0u; cnt = 0u; mine = 0u;
#pragma unroll
    for (unsigned j = 0; j < 16; ++j) { const unsigned c = xb_ld(&bar[XB_XCNT(j)]); sum += c; cnt += (c > 0u) ? 1u : 0u; mine = (j == x) ? c : mine; }
    if (sum == G) break;
    __builtin_amdgcn_s_sleep(1);
    if ((++sp & 255u) == 0u) { if (xb_ld(&bar[XB_TMO])) break; if (sp > XB_SPIN_CAP) { atomicAdd(&bar[XB_TMO], 1u); break; } }
  }
  nloc = mine > 0u ? mine : 1u; nx = cnt > 0u ? cnt : 1u;
}
DI void xcd_barrier(unsigned* bar, volatile LAS unsigned* st) {
  asm volatile("s_waitcnt vmcnt(0)" ::: "memory");
  __syncthreads();
  if (threadIdx.x == 0) {
    __builtin_amdgcn_s_waitcnt(0);
    const unsigned x = xb_xcc_id();
    unsigned nloc = st[0], nx = st[1];
    if (nloc == 0u) { xcd_barrier_complete(bar, x, nloc, nx); st[0] = nloc; st[1] = nx; }
    const unsigned old = xb_add(&bar[XB_XSUB(x)], 1u);
    const unsigned gen = old / nloc;
    if (old + 1u == (gen + 1u) * nloc) {
      __builtin_amdgcn_fence(__ATOMIC_RELEASE, "agent");
      asm volatile("s_waitcnt vmcnt(0)" ::: "memory");
      const unsigned og = xb_add(&bar[XB_TOP], 1u);
      const unsigned tg = og / nx;
      if (og + 1u == (tg + 1u) * nx) xb_add(&bar[XB_TOPGEN], 1u);
      else XB_SPIN(xb_ld(&bar[XB_TOPGEN]) == tg, bar);
      __builtin_amdgcn_fence(__ATOMIC_ACQUIRE, "agent");
      xb_add(&bar[XB_XGEN(x)], 1u);
      asm volatile("s_waitcnt vmcnt(0)" ::: "memory");
    } else {
      XB_SPIN(xb_ld(&bar[XB_XGEN(x)]) == gen, bar);
      __builtin_amdgcn_fence(__ATOMIC_ACQUIRE, "agent");
      asm volatile("s_waitcnt vmcnt(0)" ::: "memory");
    }
  }
  __syncthreads();
}

constexpr int NPH = 12;
DI void run_phase(const Params& p, int l, int ph, char* smem, int dry = 0) {
  asm volatile("" : "+s"(l));
  switch (ph) {
    case 0: phase_A(p, l, smem); break;
    case 1: phase_G1(p, smem); break;
    case 2: phase_pre(p, l); break;
    case 3: phase_prep(p, l, smem); break;
    case 4: phase_mix(p, l, smem, dry); break;
    case 11: phase_attn(p, l, smem, dry); break;
    case 5: phase_post(p, l, smem); break;
    case 6: phase_G2(p, l, smem); break;
    case 7: phase_resid(p, p.MERGED, DM, p.WoutT, XLD, smem, dry); break;
    case 8: rmsnorm_rows(p.out, p.norm_ffn + l * DM, p.XN, nullptr); break;
    case 9: phase_G4(p, smem); break;
    case 10: phase_resid(p, p.H, FH, p.WdownT, FH, smem, dry); break;
    default: break;
  }
}

#if MULTI
template <int PH>
__global__ void __launch_bounds__(NTHR) k_phase(Params p, int l) {
  __shared__ __attribute__((aligned(16))) char smem[SMEM_BYTES];
  if (PH < NPH) run_phase(p, l, PH, smem);
  else phase_final(p);
}
#else
__global__ void __launch_bounds__(NTHR) k_mega(Params p) {
  __shared__ __attribute__((aligned(16))) char smem[SMEM_BYTES];
  cg::grid_group grid = cg::this_grid();
  __shared__ uint4 xb_words;
  if (threadIdx.x == 0) xb_words = make_uint4(0u, 0u, 0u, 0u);
  __syncthreads();
  unsigned* bar = (unsigned*)p.ctr;
  if (blockIdx.x == 0) for (int i = threadIdx.x; i < XCD_BAR_WORDS; i += NTHR) bar[i] = 0u;
  for (int l = 0; l < 2; ++l) {
#pragma unroll 1
    for (int i = 0; i < NPH; ++i) {
      const int ph = i < 4 ? i : (i == 4 ? 11 : i - 1);
      run_phase(p, l, ph, smem);
      if (l == 0 && i == 0) { grid.sync(); xcd_barrier_post(bar); }
      else xcd_barrier(bar, (volatile LAS unsigned*)&xb_words);
    }
  }
  phase_final(p);
}
#endif

extern "C" void kernel_launch(void* const* d_in, const int* in_sizes, int n_in, void* d_out, int out_size, void* d_ws, size_t ws_size,
                              hipStream_t stream) {
  Params p{};
  const float** pf = (const float**)&p;
  for (int i = 0; i < 34; ++i) pf[i] = (const float*)d_in[i];
  p.out = (float*)d_out;
  char* ws = (char*)d_ws;
  size_t off = 0;
  auto take = [&](size_t bytes) { char* r = ws + off; off += (bytes + 255) & ~(size_t)255; return r; };
  p.ctr = (int*)take(16384);
  p.WinT = (u16*)take((size_t)PLD * XLD * 2);
  p.WgT = (u16*)take((size_t)3072 * XLD * 2);
  p.WbrT = (u16*)take((size_t)3 * 1024 * 512 * 2);
  p.WoutT = (u16*)take((size_t)1024 * XLD * 2);
  p.w2T = (u16*)take(512 * 64 * 2);
  p.a2T = (u16*)take(512 * 64 * 2);
  p.g2T = (u16*)take(512 * 192 * 2);
  p.v2T = (u16*)take(512 * 64 * 2);
  char* shared = take((size_t)M_TOK * LALD * 2);
  p.LA = (u16*)shared;
  p.WguT = (u16*)shared;
  p.WdownT = (u16*)(shared + (size_t)2 * FH * XLD * 2);
  p.XN = (u16*)take((size_t)M_TOK * XLD * 2);
  p.PROJ = (u16*)take((size_t)M_TOK * PLD * 2);
  p.H = p.PROJ;
  p.VF = (u16*)take((size_t)M_TOK * 512 * 2);
  p.AA = (u16*)take((size_t)M_TOK * 512 * 2);
  p.WR = (u16*)take((size_t)M_TOK * 512 * 2);
  p.GG = (u16*)take((size_t)M_TOK * 512 * 2);
  p.MERGED = p.AA;
  if (off > ws_size || n_in != 34) { fprintf(stderr, "kernel_launch: workspace too small (%zu needed, %zu given) or n_in %d\n", off, ws_size, n_in); return; }
#if MULTI
#define LP(PH) hipLaunchKernelGGL(k_phase<PH>, dim3(256), dim3(NTHR), 0, stream, p, l)
  for (int l = 0; l < 2; ++l) { LP(0); LP(1); LP(2); LP(3); LP(11); LP(4); LP(5); LP(6); LP(7); LP(8); LP(9); LP(10); }
  { int l = 0; LP(12); }
#else
  static int grid = 0;
  if (!grid) {
    int dev = 0, cus = 0, per_cu = 0;
    hipGetDevice(&dev);
    hipDeviceGetAttribute(&cus, hipDeviceAttributeMultiprocessorCount, dev);
    (void)hipOccupancyMaxActiveBlocksPerMultiprocessor(&per_cu, k_mega, NTHR, 0);
    if (per_cu < 1) per_cu = 1;
    if (per_cu > 1) per_cu = 1;
    grid = cus * per_cu;
  }
  void* args[] = {&p};
  hipError_t e = hipLaunchCooperativeKernel((void*)k_mega, dim3(grid), dim3(NTHR), args, 0, stream);
  if (e != hipSuccess) fprintf(stderr, "cooperative launch failed: %s (grid %d)\n", hipGetErrorString(e), grid);
#endif
}
```

```cpp
#include <hip/hip_runtime.h>
#include <hip/hip_cooperative_groups.h>
#include <cstdio>
#include <cstdint>
namespace cg = cooperative_groups;

#ifndef MULTI
#define MULTI 0
#endif

typedef unsigned short u16;
typedef short bf16x8 __attribute__((ext_vector_type(8)));
typedef short s16x4 __attribute__((ext_vector_type(4)));
typedef float f32x16 __attribute__((ext_vector_type(16)));
typedef float f32x4 __attribute__((ext_vector_type(4)));
typedef float f32x2 __attribute__((ext_vector_type(2)));
typedef unsigned u32x4 __attribute__((ext_vector_type(4)));

#define DI __device__ __forceinline__
#define MFMA(a, b, c) __builtin_amdgcn_mfma_f32_32x32x16_bf16((a), (b), (c), 0, 0, 0)
#define MFMA16(a, b, c) __builtin_amdgcn_mfma_f32_16x16x32_bf16((a), (b), (c), 0, 0, 0)

constexpr int M_TOK = 32768;
constexpr int SEQ = 2048;
constexpr int DM = 1024;
constexpr int PLD = 4224;
constexpr int C_R = 0, C_K = 512, C_V = 1024, C_LW = 1536, C_LA = 1600, C_LG = 1664;
constexpr int C_LV = 1824, C_Z = 1856, C_XBC = 2368, C_DT = 3392, C_Q = 3456, C_AK = 3968, C_AV = 4096;
constexpr int LALD = 384;
constexpr int XLD = 1088;
constexpr int FH = 2816;
constexpr int SMEM_BYTES = 147456;
constexpr int NTHR = 512;
constexpr int NWV = 8;

struct Params {
  const float* x; const float* norm_mix; const float* w_in; const float* rw_mu; const float* rw_w0; const float* rw_w2;
  const float* rw_a0; const float* rw_a2; const float* rw_g2; const float* rw_k_k; const float* rw_k_a; const float* rw_r_k;
  const float* rw_gn_w; const float* rw_gn_b; const float* vres_down; const float* vres_mu; const float* vres_v0; const float* vres_v2;
  const float* conv_w; const float* conv_b; const float* dt_bias; const float* a_log; const float* ssm_d; const float* ssm_norm_w;
  const float* sinks; const float* gate_b; const float* w_br_rw; const float* w_br_ssm; const float* w_br_att; const float* w_out;
  const float* norm_ffn; const float* w_gu; const float* w_down; const float* norm_final;
  float* out;
  u16 *WinT, *WgT, *WbrT, *WoutT, *w2T, *a2T, *g2T, *v2T, *WguT, *WdownT, *LA, *XN, *PROJ, *VF, *AA, *WR, *GG, *MERGED, *H;
  int* ctr;
};

DI int tidx_() { int t = (int)__builtin_amdgcn_workitem_id_x(); asm volatile("" : "+v"(t)); return t; }
DI int bidx_() { int t = (int)__builtin_amdgcn_workgroup_id_x(); asm volatile("" : "+s"(t)); return t; }
DI int gdim_() { int t = (int)gridDim.x; asm volatile("" : "+s"(t)); return t; }
#define TIDX tidx_()
#define BIDX bidx_()
#define GDIM gdim_()

DI float bf2f(u16 v) { return __uint_as_float(((unsigned)v) << 16); }
DI u16 f2bf(float f) { unsigned u = __float_as_uint(f); u += 0x7fffu + ((u >> 16) & 1u); return (u16)(u >> 16); }
DI unsigned pack2(float a, float b) { return (unsigned)f2bf(a) | ((unsigned)f2bf(b) << 16); }
DI unsigned cvt_pk_bf16(float a, float b) { unsigned r; asm volatile("s_nop 4\n\tv_cvt_pk_bf16_f32 %0, %1, %2\n\ts_nop 1" : "=v"(r) : "v"(a), "v"(b)); return r; }
DI float sigmoidf_(float x) { return __builtin_amdgcn_rcpf(1.f + __expf(-x)); }
DI float siluf_(float x) { return x * sigmoidf_(x); }
DI float tanhf_(float x) { return 1.f - 2.f * __builtin_amdgcn_rcpf(1.f + __expf(2.f * x)); }
DI float softplusf_(float z) { return z > 20.f ? z : __logf(1.f + __expf(z)); }
DI int crow(int r, int h) { return (r & 3) + 8 * (r >> 2) + 4 * h; }
DI float dppf(float x, const int ctrl_sel) {
  int xi = __float_as_int(x);
  int r;
  if (ctrl_sel == 0) r = __builtin_amdgcn_update_dpp(0, xi, 0xB1, 0xF, 0xF, true);
  else if (ctrl_sel == 1) r = __builtin_amdgcn_update_dpp(0, xi, 0x4E, 0xF, 0xF, true);
  else r = __builtin_amdgcn_update_dpp(0, xi, 0x141, 0xF, 0xF, true);
  return __int_as_float(r);
}
DI float red8(float x) {
  x += dppf(x, 0);
  x += dppf(x, 1);
  x += dppf(x, 2);
  return x;
}
DI float red4(float x) {
  x += dppf(x, 0);
  x += dppf(x, 1);
  return x;
}
DI float red16(float x) {
  x = red8(x);
  x += __int_as_float(__builtin_amdgcn_update_dpp(0, __float_as_int(x), 0x140, 0xF, 0xF, true));
  return x;
}
DI float wave_sum(float v) {
  v = red8(v);
  v += __int_as_float(__builtin_amdgcn_update_dpp(0, __float_as_int(v), 0x140, 0xF, 0xF, true));
  const float r0 = __int_as_float(__builtin_amdgcn_readlane(__float_as_int(v), 0));
  const float r1 = __int_as_float(__builtin_amdgcn_readlane(__float_as_int(v), 16));
  const float r2 = __int_as_float(__builtin_amdgcn_readlane(__float_as_int(v), 32));
  const float r3 = __int_as_float(__builtin_amdgcn_readlane(__float_as_int(v), 48));
  return (r0 + r1) + (r2 + r3);
}

__device__ void cvt_T(const float* __restrict__ src, int K, int ld, int c0, int ncols, u16* __restrict__ dst, int dld, int r0,
                      int mode, char* smem) {
  float* tl = (float*)smem;
  const int ct = (ncols + 31) >> 5, kt = (K + 63) >> 6;
  const int tid = TIDX;
  const int nt = ct * kt, gd = GDIM;
  const int rk = tid >> 5, rc = tid & 31;
  float v[4];
  auto LOADT = [&](int t) {
    const int cb = (t % ct) * 32, kb = (t / ct) * 64;
#pragma unroll
    for (int i = 0; i < 4; ++i) {
      const int k = rk + 16 * i;
      v[i] = 0.f;
      if (cb + rc < ncols && kb + k < K) v[i] = src[(size_t)(kb + k) * ld + c0 + cb + rc];
    }
  };
  int t = BIDX;
  if (t < nt) LOADT(t);
  for (; t < nt; t += gd) {
    const int cb = (t % ct) * 32, kb = (t / ct) * 64;
    __syncthreads();
#pragma unroll
    for (int i = 0; i < 4; ++i) tl[rc * 65 + rk + 16 * i] = v[i];
    __syncthreads();
    if (t + gd < nt) LOADT(t + gd);
    {
      const int c = tid >> 4, kc = tid & 15;
      if (cb + c < ncols) {
        int drow;
        if (mode == 0) drow = r0 + cb + c;
        else { const int ty = cb >= FH ? 1 : 0; const int j0 = cb - ty * FH; drow = (j0 >> 5) * 64 + ty * 32 + c; }
        const float* sp = tl + c * 65 + kc * 4;
        uint2 o; o.x = pack2(sp[0], sp[1]); o.y = pack2(sp[2], sp[3]);
        *(uint2*)(dst + (size_t)drow * dld + kb + kc * 4) = o;
      }
    }
  }
  __syncthreads();
}

template <int NI>
DI void gemm_core(f32x4 (&acc)[2 * NI][4], const u16* __restrict__ A, int lda, const u16* __restrict__ W, int ldw, int K, char* smem,
                  u32x4 (&ra)[4], u32x4 (&rw)[NI], bool pre, const u16* nA, int nlda, const u16* nW, int nldw) {
  constexpr int A_ELEMS = 256 * 64;
  constexpr int W_ELEMS = 64 * NI * 64;
  u16* As = (u16*)smem;
  u16* Ws = As + 2 * A_ELEMS;
  const int tid = TIDX, lane = tid & 63, wave = tid >> 6;
  const int wm = wave >> 1, wn = wave & 1, fr = lane & 15, fq = lane >> 4;
  const int lr = tid >> 3, lc = tid & 7;
  unsigned opq = 0;
  asm volatile("" : "+v"(opq));
  const u16* ag = A + (size_t)lr * lda + lc * 8 + opq;
  const u16* wg = W + (size_t)lr * ldw + lc * 8 + opq;
  const int sw_st = (lc ^ ((lr >> 1) & 7)) * 8;
  auto GLOAD = [&](int k0) {
#pragma unroll
    for (int i = 0; i < 4; ++i) ra[i] = *(const u32x4*)(ag + (size_t)(64 * i) * lda + k0);
#pragma unroll
    for (int i = 0; i < NI; ++i) rw[i] = *(const u32x4*)(wg + (size_t)(64 * i) * ldw + k0);
  };
  auto GLOADNEXT = [&]() {
    const u16* ag2 = nA + (size_t)lr * nlda + lc * 8 + opq;
    const u16* wg2 = nW + (size_t)lr * nldw + lc * 8 + opq;
#pragma unroll
    for (int i = 0; i < 4; ++i) ra[i] = *(const u32x4*)(ag2 + (size_t)(64 * i) * nlda);
#pragma unroll
    for (int i = 0; i < NI; ++i) rw[i] = *(const u32x4*)(wg2 + (size_t)(64 * i) * nldw);
  };
  auto SSTORE = [&](int buf) {
#pragma unroll
    for (int i = 0; i < 4; ++i) *(u32x4*)(As + buf * A_ELEMS + (lr + 64 * i) * 64 + sw_st) = ra[i];
#pragma unroll
    for (int i = 0; i < NI; ++i) *(u32x4*)(Ws + buf * W_ELEMS + (lr + 64 * i) * 64 + sw_st) = rw[i];
  };
  const int swz = fr >> 1;
  const int off0 = ((0 + fq) ^ swz) * 8, off1 = ((4 + fq) ^ swz) * 8;
  const int KT = K >> 6;
  if (!pre) GLOAD(0);
  SSTORE(0);
  if (KT > 1) GLOAD(64);
  else if (nA) GLOADNEXT();
  __syncthreads();
#pragma unroll 1
  for (int kt = 0; kt < KT; ++kt) {
    const int buf = kt & 1;
    if (kt + 1 < KT) {
      SSTORE(buf ^ 1);
      if (kt + 2 < KT) GLOAD((kt + 2) * 64);
      else if (nA) GLOADNEXT();
    }
    const u16* as = As + buf * A_ELEMS + (wm * 64 + fr) * 64;
    const u16* ws = Ws + buf * W_ELEMS + (wn * 32 * NI + fr) * 64;
#pragma unroll
    for (int ks = 0; ks < 2; ++ks) {
      const int off = ks ? off1 : off0;
      bf16x8 wf[2 * NI], af[4];
#pragma unroll
      for (int nb = 0; nb < 2 * NI; ++nb) wf[nb] = *(const bf16x8*)(ws + nb * 16 * 64 + off);
#pragma unroll
      for (int mb = 0; mb < 4; ++mb) af[mb] = *(const bf16x8*)(as + mb * 16 * 64 + off);
#pragma unroll
      for (int nb = 0; nb < 2 * NI; ++nb)
#pragma unroll
        for (int mb = 0; mb < 4; ++mb) acc[nb][mb] = MFMA16(wf[nb], af[mb], acc[nb][mb]);
    }
    __syncthreads();
  }
}
template <int NI>
DI void gemm_core(f32x4 (&acc)[2 * NI][4], const u16* __restrict__ A, int lda, const u16* __restrict__ W, int ldw, int K, char* smem) {
  u32x4 ra[4], rw[NI];
  gemm_core<NI>(acc, A, lda, W, ldw, K, smem, ra, rw, false, nullptr, 0, nullptr, 0);
}

template <int NI>
DI void zero_acc(f32x4 (&acc)[2 * NI][4]) {
#pragma unroll
  for (int nb = 0; nb < 2 * NI; ++nb)
#pragma unroll
    for (int mb = 0; mb < 4; ++mb) acc[nb][mb] = f32x4{0.f, 0.f, 0.f, 0.f};
}

template <int NI, typename F>
DI void epilogue(f32x4 (&acc)[2 * NI][4], char* smem, F epi) {
  constexpr int SLD = 132;
  float* st = (float*)smem;
  const int tid = TIDX, lane = tid & 63, wave = tid >> 6;
  const int wm = wave >> 1, wn = wave & 1, fr = lane & 15, fq = lane >> 4;
#pragma unroll
  for (int q = 0; q < NI / 2; ++q) {
#pragma unroll
    for (int nn = 0; nn < 4; ++nn)
#pragma unroll
      for (int mb = 0; mb < 4; ++mb)
        *(f32x4*)(st + (wm * 64 + mb * 16 + fr) * SLD + wn * 64 + nn * 16 + fq * 4) = acc[4 * q + nn][mb];
    __syncthreads();
    for (int idx = tid; idx < 256 * 32; idx += NTHR) {
      const int row = idx >> 5, sc = (idx & 31) * 4;
      f32x4 v = *(const f32x4*)(st + row * SLD + sc);
      epi(row, (sc >> 6) * (32 * NI) + q * 64 + (sc & 63), v);
    }
    __syncthreads();
  }
}

DI bool next_tile(int k, int MT, int NT, int& mt, int& nt) {
  const int bid = BIDX, gd = GDIM;
  int tl = (gd == 256) ? k * 256 + (bid & 7) * 32 + (bid >> 3) : k * gd + bid;
  if (tl >= MT * NT) return false;
  const int band = tl / (MT * 8);
  const int w = (NT - band * 8) < 8 ? (NT - band * 8) : 8;
  const int within = tl - band * MT * 8;
  mt = within / w;
  nt = band * 8 + within % w;
  return true;
}

DI void lds_barrier() { asm volatile("s_waitcnt lgkmcnt(0)\n\ts_barrier" ::: "memory"); }

template <int NI, bool NT = false, typename F>
DI void epilogue_bf16(f32x4 (&acc)[2 * NI][4], char* smem, u16* dst, int ld, F tr) {
  constexpr int SLD = 264;
  u16* st = (u16*)smem;
  const int tid = TIDX, lane = tid & 63, wave = tid >> 6;
  const int wm = wave >> 1, wn = wave & 1, fr = lane & 15, fq = lane >> 4;
#pragma unroll
  for (int nb = 0; nb < 2 * NI; ++nb)
#pragma unroll
    for (int mb = 0; mb < 4; ++mb) {
      const int row = wm * 64 + mb * 16 + fr, col = wn * 32 * NI + nb * 16 + fq * 4;
      const f32x4 v = tr(row, col, acc[nb][mb]);
      uint2 o; o.x = pack2(v[0], v[1]); o.y = pack2(v[2], v[3]);
      *(uint2*)(st + row * SLD + col) = o;
    }
  lds_barrier();
  constexpr int CH = 8 * NI;
  for (int idx = tid; idx < 256 * CH; idx += NTHR) {
    const int row = idx / CH, ch = idx % CH;
    const u32x4 v = *(const u32x4*)(st + row * SLD + ch * 8);
    if (NT) __builtin_nontemporal_store(v, (u32x4*)(dst + (size_t)row * ld + ch * 8));
    else *(u32x4*)(dst + (size_t)row * ld + ch * 8) = v;
  }
  lds_barrier();
}

DI void store_bf4(u16* dst, f32x4 v) {
  uint2 o; o.x = pack2(v[0], v[1]); o.y = pack2(v[2], v[3]);
  *(uint2*)dst = o;
}

__device__ void rmsnorm_rows(const float* xin, const float* __restrict__ w, u16* xn, float* copy_to) {
  const int lane = TIDX & 63;
  const int gw = BIDX * NWV + (TIDX >> 6), nw = GDIM * NWV;
  for (int row = gw; row < M_TOK; row += nw) {
    const float* xr = xin + (size_t)row * DM;
    f32x4 v[4];
    float ss = 0.f;
#pragma unroll
    for (int i = 0; i < 4; ++i) {
      v[i] = *(const f32x4*)(xr + i * 256 + lane * 4);
      ss += v[i][0] * v[i][0] + v[i][1] * v[i][1] + v[i][2] * v[i][2] + v[i][3] * v[i][3];
    }
    ss = wave_sum(ss);
    const float rstd = rsqrtf(ss * (1.f / DM) + 1e-6f);
#pragma unroll
    for (int i = 0; i < 4; ++i) {
      const f32x4 ww = *(const f32x4*)(w + i * 256 + lane * 4);
      f32x4 o = {v[i][0] * rstd * ww[0], v[i][1] * rstd * ww[1], v[i][2] * rstd * ww[2], v[i][3] * rstd * ww[3]};
      if (xn) store_bf4(xn + (size_t)row * XLD + i * 256 + lane * 4, o);
      else *(f32x4*)(copy_to + (size_t)row * DM + i * 256 + lane * 4) = o;
      if (xn && copy_to) *(f32x4*)(copy_to + (size_t)row * DM + i * 256 + lane * 4) = v[i];
    }
  }
}

__device__ void phase_A(const Params& p, int l, char* smem) {
  const float* win = p.w_in + (size_t)l * DM * 7208;
  cvt_T(win, 1024, 7208, 0, 1824, p.WinT, XLD, 0, 0, smem);
  cvt_T(win, 1024, 7208, 1824, 1544, p.WinT, XLD, C_Z, 0, smem);
  cvt_T(win, 1024, 7208, 3368, 768, p.WinT, XLD, C_Q, 0, smem);
  if (l == 1) cvt_T(p.vres_down, 1024, 32, 0, 32, p.WinT, XLD, C_LV, 0, smem);
  cvt_T(win, 1024, 7208, 4136, 3072, p.WgT, XLD, 0, 0, smem);
  cvt_T(p.w_br_rw + (size_t)l * 512 * 1024, 512, 1024, 0, 1024, p.WbrT, 512, 0, 0, smem);
  cvt_T(p.w_br_ssm + (size_t)l * 512 * 1024, 512, 1024, 0, 1024, p.WbrT + 1024 * 512, 512, 0, 0, smem);
  cvt_T(p.w_br_att + (size_t)l * 512 * 1024, 512, 1024, 0, 1024, p.WbrT + 2 * 1024 * 512, 512, 0, 0, smem);
  cvt_T(p.w_out + (size_t)l * 1024 * 1024, 1024, 1024, 0, 1024, p.WoutT, XLD, 0, 0, smem);
  cvt_T(p.rw_w2 + (size_t)l * 64 * 512, 64, 512, 0, 512, p.w2T, 64, 0, 0, smem);
  cvt_T(p.rw_a2 + (size_t)l * 64 * 512, 64, 512, 0, 512, p.a2T, 64, 0, 0, smem);
  cvt_T(p.rw_g2 + (size_t)l * 160 * 512, 160, 512, 0, 512, p.g2T, 192, 0, 0, smem);
  if (l == 1) cvt_T(p.vres_v2, 32, 512, 0, 512, p.v2T, 64, 0, 0, smem);
  if (l == 0) rmsnorm_rows(p.x, p.norm_mix, p.XN, p.out);
  else rmsnorm_rows(p.out, p.norm_mix + DM, p.XN, nullptr);
}

__device__ void phase_G1(const Params& p, char* smem) {
  u32x4 ra[4], rw[4];
  bool pre = false;
  int mt, j;
  bool have = next_tile(0, 128, 17, mt, j);
  for (int k = 0; have; ++k) {
    int mt2 = 0, j2 = 0;
    const bool have2 = next_tile(k + 1, 128, 17, mt2, j2);
    const u16* A = p.XN + (size_t)mt * 256 * XLD;
    u16* dst = p.PROJ + (size_t)mt * 256 * PLD + j * 256;
    if (j < 16) {
      const bool nx = have2 && j2 < 16;
      f32x4 acc[8][4];
      zero_acc<4>(acc);
      gemm_core<4>(acc, A, XLD, p.WinT + (size_t)j * 256 * XLD, XLD, DM, smem, ra, rw, pre,
                   nx ? p.XN + (size_t)mt2 * 256 * XLD : nullptr, XLD, p.WinT + (size_t)j2 * 256 * XLD, XLD);
      pre = nx;
      epilogue_bf16<4, true>(acc, smem, dst, PLD, [&](int, int, f32x4 v) { return v; });
    } else {
      f32x4 acc[4][4];
      zero_acc<2>(acc);
      gemm_core<2>(acc, A, XLD, p.WinT + (size_t)j * 256 * XLD, XLD, DM, smem);
      pre = false;
      epilogue_bf16<2, true>(acc, smem, dst, PLD, [&](int, int, f32x4 v) { return v; });
    }
    mt = mt2; j = j2; have = have2;
  }
}

__device__ void phase_pre(const Params& p, int l) {
  const int lane = TIDX & 63;
  const int gw = BIDX * NWV + (TIDX >> 6), nw = GDIM * NWV;
  const float* mu = p.rw_mu + l * 1824;
  for (int row = gw; row < M_TOK; row += nw) {
    const bool hp = (row & (SEQ - 1)) != 0;
    const u16* pr = p.PROJ + (size_t)row * PLD;
    const u16* pp = pr - PLD;
    u16* la = p.LA + (size_t)row * LALD;
    auto mix = [&](int colp, float m) {
      const float a = bf2f(pr[colp]);
      const float b = hp ? bf2f(pp[colp]) : 0.f;
      return a + (b - a) * m;
    };
    la[lane] = f2bf(tanhf_(mix(C_LW + lane, mu[C_LW + lane])));
    la[64 + lane] = f2bf(mix(C_LA + lane, mu[C_LA + lane]));
    la[128 + lane] = f2bf(sigmoidf_(mix(C_LG + lane, mu[C_LG + lane])));
    la[192 + lane] = f2bf(sigmoidf_(mix(C_LG + 64 + lane, mu[C_LG + 64 + lane])));
    u16 e4 = 0;
    if (lane < 32) e4 = f2bf(sigmoidf_(mix(C_LG + 128 + lane, mu[C_LG + 128 + lane])));
    la[256 + lane] = e4;
    u16 e5 = 0;
    if (l == 1 && lane < 32) e5 = f2bf(mix(C_LV + lane, p.vres_mu[lane]));
    la[320 + lane] = e5;
    if (l == 0) {
#pragma unroll
      for (int j = 0; j < 8; ++j) {
        const int c = lane + 64 * j;
        p.VF[(size_t)row * 512 + c] = f2bf(mix(C_V + c, mu[C_V + c]));
      }
    }
  }
}

__device__ void phase_prep(const Params& p, int l, char* smem) {
  const int nk = (l == 1) ? 4 : 3;
  for (int k = 0;; ++k) {
    int mt, kn;
    if (!next_tile(k, 128, 2 * nk, mt, kn)) break;
    const int kind = kn >> 1, nt = kn & 1;
    const int koff = kind == 0 ? 0 : (kind == 1 ? 64 : (kind == 2 ? 128 : 320));
    const int Kk = kind == 2 ? 192 : 64;
    const u16* Wk = kind == 0 ? p.w2T : (kind == 1 ? p.a2T : (kind == 2 ? p.g2T : p.v2T));
    f32x4 acc[8][4];
    zero_acc<4>(acc);
    gemm_core<4>(acc, p.LA + (size_t)mt * 256 * LALD + koff, LALD, Wk + (size_t)nt * 256 * Kk, Kk, Kk, smem);
    const int m0 = mt * 256, n0 = nt * 256;
    if (kind == 0) {
      const float* w0 = p.rw_w0 + l * 512 + n0;
      epilogue_bf16<4>(acc, smem, p.WR + (size_t)m0 * 512 + n0, 512, [&](int, int col, f32x4 v) {
        const f32x4 b = *(const f32x4*)(w0 + col);
        f32x4 o = {v[0] + b[0], v[1] + b[1], v[2] + b[2], v[3] + b[3]};
        return o;
      });
    } else if (kind == 1) {
      const float* a0 = p.rw_a0 + l * 512 + n0;
      epilogue_bf16<4>(acc, smem, p.AA + (size_t)m0 * 512 + n0, 512, [&](int, int col, f32x4 v) {
        const f32x4 b = *(const f32x4*)(a0 + col);
        f32x4 o = {sigmoidf_(v[0] + b[0]), sigmoidf_(v[1] + b[1]), sigmoidf_(v[2] + b[2]), sigmoidf_(v[3] + b[3])};
        return o;
      });
    } else if (kind == 2) {
      epilogue_bf16<4>(acc, smem, p.GG + (size_t)m0 * 512 + n0, 512, [&](int, int, f32x4 v) { return v; });
    } else {
      const float* v0 = p.vres_v0 + n0;
      const float* mu = p.rw_mu + l * 1824 + C_V + n0;
      epilogue<4>(acc, smem, [&](int row, int col, f32x4 v) {
        const int m = m0 + row;
        const bool hp = (m & (SEQ - 1)) != 0;
        const u16* pr = p.PROJ + (size_t)m * PLD + C_V + n0 + col;
        u16* vf = p.VF + (size_t)m * 512 + n0 + col;
        f32x4 o;
#pragma unroll
        for (int j = 0; j < 4; ++j) {
          const float a = bf2f(pr[j]);
          const float b = hp ? bf2f(pr[j - PLD]) : 0.f;
          const float vv = a + (b - a) * mu[col + j];
          const float gate = sigmoidf_(v0[col + j] + v[j]);
          const float f = bf2f(vf[j]);
          o[j] = vv + (f - vv) * gate;
        }
        store_bf4(vf, o);
      });
    }
  }
}

__device__ void rwkv_item(const Params& p, int l, int item, char* smem, int dry) {
  const int b = item >> 3, hh = item & 7;
  const int tid = TIDX, lane = tid & 63, wave = tid >> 6;
  float* stg = (float*)smem;
  float* ybuf = stg + 2 * 16 * 448;
  float* bon = ybuf + 16 * 4 * 64;
  const int col = hh * 64 + lane;
  const float mu_r = p.rw_mu[l * 1824 + C_R + col], mu_k = p.rw_mu[l * 1824 + C_K + col];
  const float kk_w = p.rw_k_k[l * 512 + col], ka_w = p.rw_k_a[l * 512 + col], rk_w = p.rw_r_k[l * 512 + col];
  const float gnw = p.rw_gn_w[l * 512 + col], gnb = p.rw_gn_b[l * 512 + col];
  const size_t row0 = (size_t)b * SEQ;
  const int r0 = wave * 8 + (lane >> 4) * 2, c = lane & 15;
  f32x2 Sa[2], Sb[2];
#pragma unroll
  for (int i = 0; i < 2; ++i) { Sa[i] = f32x2{0.f, 0.f}; Sb[i] = f32x2{0.f, 0.f}; }
  u16 q_rt[2], q_rp[2], q_kt[2], q_kp[2], q_v[2], q_a[2], q_w[2], q_g[2];
#define RW_LOAD(t0)                                                                                 \
  {                                                                                                 \
    int pin_ = 1;                                                                                   \
    asm volatile("" : "+s"(pin_));                                                                  \
    _Pragma("unroll") for (int i = 0; i < 2; ++i) {                                                 \
      q_rt[i] = 0; q_kt[i] = 0; q_rp[i] = 0; q_kp[i] = 0; q_v[i] = 0; q_a[i] = 0; q_w[i] = 0; q_g[i] = 0; \
    }                                                                                               \
    if (pin_) {                                                                                     \
    _Pragma("unroll") for (int i = 0; i < 2; ++i) {                                                 \
      const int t = (t0) + wave + 8 * i;                                                            \
      const size_t row = row0 + t;                                                                  \
      const u16* pr = p.PROJ + row * PLD;                                                           \
      q_rt[i] = pr[C_R + col]; q_kt[i] = pr[C_K + col];                                             \
      q_rp[i] = t > 0 ? pr[C_R + col - PLD] : (u16)0; q_kp[i] = t > 0 ? pr[C_K + col - PLD] : (u16)0; \
      q_v[i] = p.VF[row * 512 + col]; q_a[i] = p.AA[row * 512 + col];                               \
      q_w[i] = p.WR[row * 512 + col]; q_g[i] = p.GG[row * 512 + col];                               \
    }                                                                                               \
    }                                                                                               \
  }
#define RW_FILL(buf)                                                                                \
  {                                                                                                 \
    _Pragma("unroll") for (int i = 0; i < 2; ++i) {                                                 \
      const int tt = wave + 8 * i;                                                                  \
      const float rt = bf2f(q_rt[i]), kt_ = bf2f(q_kt[i]);                                          \
      const float r = rt + (bf2f(q_rp[i]) - rt) * mu_r;                                             \
      const float kx = kt_ + (bf2f(q_kp[i]) - kt_) * mu_k;                                          \
      const float aa = bf2f(q_a[i]);                                                                \
      const float kkv = kx * kk_w;                                                                  \
      const float nrm = sqrtf(wave_sum(kkv * kkv));                                                 \
      const float kkn = kkv / fmaxf(nrm, 1e-12f);                                                   \
      const float knew = kx * (1.f + (aa - 1.f) * ka_w);                                            \
      const float wl = -softplusf_(-bf2f(q_w[i])) - 0.5f;                                           \
      const float wdec = __expf(-__expf(wl));                                                       \
      float* s = stg + ((buf) * 16 + tt) * 448;                                                     \
      s[lane] = r; s[64 + lane] = wdec; s[128 + lane] = knew; s[192 + lane] = -kkn;                 \
      s[256 + lane] = kkn * aa; s[320 + lane] = bf2f(q_v[i]); s[384 + lane] = bf2f(q_g[i]);         \
      const float bs = wave_sum(r * knew * rk_w);                                                   \
      if (lane == 0) bon[(buf) * 16 + tt] = bs;                                                     \
    }                                                                                               \
  }
  __syncthreads();
  RW_LOAD(0);
  RW_FILL(0);
  __syncthreads();
  for (int ch = 0; ch < SEQ / 16; ++ch) {
    const int buf = ch & 1, t0 = ch * 16;
    {
    if (ch + 1 < SEQ / 16) RW_LOAD(t0 + 16);
    {
      f32x4 op[2][5];
      f32x2 ov[2];
      const float* sb = stg + buf * 16 * 448 + c * 4;
#define RW_LDOPS(tt, q)                                                        \
      {                                                                        \
        const float* s_ = sb + (tt) * 448;                                     \
        _Pragma("unroll") for (int u = 0; u < 5; ++u) op[q][u] = *(const f32x4*)(s_ + 64 * u); \
        ov[q] = *(const f32x2*)(stg + (buf * 16 + (tt)) * 448 + 320 + r0);     \
      }
#define PK_LO(v) __builtin_shufflevector((v), (v), 0, 1)
#define PK_HI(v) __builtin_shufflevector((v), (v), 2, 3)
      RW_LDOPS(0, 0);
#pragma unroll 1
      for (int t2 = 0; t2 < 16; t2 += 2) {
#pragma unroll
      for (int q = 0; q < 2; ++q) {
        const int tt = t2 + q;
        if (q == 0) RW_LDOPS(tt + 1, 1) else if (t2 + 2 < 16) RW_LDOPS(tt + 1, 0);
        f32x2 sA = Sa[0] * PK_LO(op[q][3]); sA += Sa[1] * PK_HI(op[q][3]);
        f32x2 sB = Sb[0] * PK_LO(op[q][3]); sB += Sb[1] * PK_HI(op[q][3]);
        const float saa = red16(sA[0] + sA[1]);
        const float sab = red16(sB[0] + sB[1]);
        const f32x2 saa2 = {saa, saa}, sab2 = {sab, sab};
        const f32x2 va2 = {ov[q][0], ov[q][0]}, vb2 = {ov[q][1], ov[q][1]};
        Sa[0] = Sa[0] * PK_LO(op[q][1]) + saa2 * PK_LO(op[q][4]) + va2 * PK_LO(op[q][2]);
        Sa[1] = Sa[1] * PK_HI(op[q][1]) + saa2 * PK_HI(op[q][4]) + va2 * PK_HI(op[q][2]);
        Sb[0] = Sb[0] * PK_LO(op[q][1]) + sab2 * PK_LO(op[q][4]) + vb2 * PK_LO(op[q][2]);
        Sb[1] = Sb[1] * PK_HI(op[q][1]) + sab2 * PK_HI(op[q][4]) + vb2 * PK_HI(op[q][2]);
        f32x2 yA = Sa[0] * PK_LO(op[q][0]); yA += Sa[1] * PK_HI(op[q][0]);
        f32x2 yB = Sb[0] * PK_LO(op[q][0]); yB += Sb[1] * PK_HI(op[q][0]);
        const float ya = red4(yA[0] + yA[1]);
        const float yb = red4(yB[0] + yB[1]);
        if ((c & 3) == 0) { f32x2 yy = {ya, yb}; *(f32x2*)(ybuf + (tt * 4 + (c >> 2)) * 64 + r0) = yy; }
      }
      }
#undef RW_LDOPS
    }
    }
    __syncthreads();
    {
#pragma unroll
    for (int i = 0; i < 2; ++i) {
      const int tt = wave + 8 * i;
      const float y = (ybuf[(tt * 4) * 64 + lane] + ybuf[(tt * 4 + 1) * 64 + lane]) + (ybuf[(tt * 4 + 2) * 64 + lane] + ybuf[(tt * 4 + 3) * 64 + lane]);
      const float mean = wave_sum(y) * (1.f / 64.f);
      const float d = y - mean;
      const float var = wave_sum(d * d) * (1.f / 64.f);
      const float yn = d * rsqrtf(var + 64e-5f) * gnw + gnb;
      const float* s = stg + (buf * 16 + tt) * 448;
      const float o = (yn + bon[buf * 16 + tt] * s[320 + lane]) * s[384 + lane];
      if (!dry) p.GG[(row0 + t0 + tt) * 512 + col] = f2bf(o);
    }
    if (ch + 1 < SEQ / 16) RW_FILL(buf ^ 1);
    }
    __syncthreads();
  }
#undef RW_LOAD
#undef RW_FILL
}

__device__ void ssd_item(const Params& p, int l, int item, char* smem, int dry) {
  const int b = item >> 3, hh = item & 7, g = hh >> 2;
  const int tid = TIDX, lane = tid & 63, wave = tid >> 6;
  constexpr int SS = 456;
  float* stg = (float*)smem;
  float* ybuf = stg + 2 * 16 * SS;
  int chn[5] = {hh * 64 + lane, 512 + g * 128 + lane, 512 + g * 128 + 64 + lane, 768 + g * 128 + lane, 768 + g * 128 + 64 + lane};
  float cw[4][5], cbv[5];
#pragma unroll
  for (int k = 0; k < 5; ++k) {
    cbv[k] = p.conv_b[l * 1024 + chn[k]];
#pragma unroll
    for (int j = 0; j < 4; ++j) cw[j][k] = p.conv_w[(l * 4 + j) * 1024 + chn[k]];
  }
  const float dtb = p.dt_bias[l * 8 + hh];
  const float Aneg = -__expf(p.a_log[l * 8 + hh]);
  const float Dsk = p.ssm_d[l * 8 + hh];
  const size_t row0 = (size_t)b * SEQ;
  const int r0 = wave * 8 + (lane >> 4) * 2, c = lane & 15;
  f32x2 Sa[4], Sb[4];
#pragma unroll
  for (int i = 0; i < 4; ++i) { Sa[i] = f32x2{0.f, 0.f}; Sb[i] = f32x2{0.f, 0.f}; }
  u16 q_x[5][5], q_z[2], q_dt[2];
#define SSD_LOAD(t0)                                                                   \
  {                                                                                    \
    _Pragma("unroll") for (int k = 0; k < 5; ++k) {                                    \
      const int t = (t0) + 2 * wave - 3 + k;                                           \
      const u16* pr = p.PROJ + (row0 + (t < 0 ? 0 : t)) * PLD + C_XBC;                 \
      _Pragma("unroll") for (int j = 0; j < 5; ++j) q_x[k][j] = t >= 0 ? pr[chn[j]] : (u16)0; \
    }                                                                                  \
    int pin_ = 1;                                                                      \
    asm volatile("" : "+s"(pin_));                                                     \
    q_z[0] = 0; q_z[1] = 0; q_dt[0] = 0; q_dt[1] = 0;                                  \
    if (pin_) {                                                                        \
    _Pragma("unroll") for (int i = 0; i < 2; ++i) {                                    \
      const u16* pr = p.PROJ + (row0 + (t0) + 2 * wave + i) * PLD;                     \
      q_z[i] = pr[C_Z + hh * 64 + lane]; q_dt[i] = pr[C_DT + hh];                      \
    }                                                                                  \
    }                                                                                  \
  }
#define SSD_FILL(buf)                                                                  \
  {                                                                                    \
    _Pragma("unroll") for (int i = 0; i < 2; ++i) {                                    \
      float cv[5];                                                                     \
      _Pragma("unroll") for (int j = 0; j < 5; ++j) {                                  \
        float a = cbv[j];                                                              \
        _Pragma("unroll") for (int k = 0; k < 4; ++k) a += cw[k][j] * bf2f(q_x[i + k][j]); \
        cv[j] = siluf_(a);                                                             \
      }                                                                                \
      const float dt = softplusf_(bf2f(q_dt[i]) + dtb);                                \
      float* s = stg + ((buf) * 16 + 2 * wave + i) * SS;                               \
      s[lane] = cv[1]; s[64 + lane] = cv[2]; s[128 + lane] = cv[3]; s[192 + lane] = cv[4]; \
      s[256 + lane] = cv[0] * dt; s[320 + lane] = cv[0]; s[384 + lane] = bf2f(q_z[i]); \
      if (lane == 0) s[448] = __expf(dt * Aneg);                                       \
    }                                                                                  \
  }
  __syncthreads();
  SSD_LOAD(0);
  SSD_FILL(0);
  __syncthreads();
  for (int ch = 0; ch < SEQ / 16; ++ch) {
    const int buf = ch & 1, t0 = ch * 16;
    {
    if (ch + 1 < SEQ / 16) SSD_LOAD(t0 + 16);
    {
      f32x4 op[2][4];
      f32x2 oxd[2];
      float oda[2];
      const float* sb = stg + buf * 16 * SS;
#define SSD_LDOPS(tt, q)                                                       \
      {                                                                        \
        const float* s_ = sb + (tt) * SS;                                      \
        op[q][0] = *(const f32x4*)(s_ + c * 8);                                \
        op[q][1] = *(const f32x4*)(s_ + c * 8 + 4);                            \
        op[q][2] = *(const f32x4*)(s_ + 128 + c * 8);                          \
        op[q][3] = *(const f32x4*)(s_ + 128 + c * 8 + 4);                      \
        oxd[q] = *(const f32x2*)(s_ + 256 + r0);                               \
        oda[q] = s_[448];                                                      \
      }
      SSD_LDOPS(0, 0);
#pragma unroll 1
      for (int t2 = 0; t2 < 16; t2 += 2) {
#pragma unroll
      for (int q = 0; q < 2; ++q) {
        const int tt = t2 + q;
        if (q == 0) SSD_LDOPS(tt + 1, 1) else if (t2 + 2 < 16) SSD_LDOPS(tt + 1, 0);
        const f32x2 dA2 = {oda[q], oda[q]};
        const f32x2 xa2 = {oxd[q][0], oxd[q][0]}, xb2 = {oxd[q][1], oxd[q][1]};
        const f32x2 B2[4] = {PK_LO(op[q][0]), PK_HI(op[q][0]), PK_LO(op[q][1]), PK_HI(op[q][1])};
        const f32x2 C2[4] = {PK_LO(op[q][2]), PK_HI(op[q][2]), PK_LO(op[q][3]), PK_HI(op[q][3])};
        f32x2 yA = {0.f, 0.f}, yB = {0.f, 0.f};
#pragma unroll
        for (int j = 0; j < 4; ++j) {
          Sa[j] = Sa[j] * dA2 + xa2 * B2[j];
          Sb[j] = Sb[j] * dA2 + xb2 * B2[j];
          yA += Sa[j] * C2[j];
          yB += Sb[j] * C2[j];
        }
        const float ya = red4(yA[0] + yA[1]);
        const float yb = red4(yB[0] + yB[1]);
        if ((c & 3) == 0) { f32x2 yy = {ya, yb}; *(f32x2*)(ybuf + (tt * 4 + (c >> 2)) * 64 + r0) = yy; }
      }
      }
#undef SSD_LDOPS
    }
    }
    __syncthreads();
    {
#pragma unroll
    for (int i = 0; i < 2; ++i) {
      const int tt = wave + 8 * i;
      const float* s = stg + (buf * 16 + tt) * SS;
      const float y = ((ybuf[(tt * 4) * 64 + lane] + ybuf[(tt * 4 + 1) * 64 + lane]) + (ybuf[(tt * 4 + 2) * 64 + lane] + ybuf[(tt * 4 + 3) * 64 + lane])) + Dsk * s[320 + lane];
      const float zz = s[384 + lane];
      if (!dry) p.PROJ[(row0 + t0 + tt) * PLD + C_Z + hh * 64 + lane] = f2bf(y * siluf_(zz));
    }
    if (ch + 1 < SEQ / 16) SSD_FILL(buf ^ 1);
    }
    __syncthreads();
  }
#undef SSD_LOAD
#undef SSD_FILL
}

__device__ void attn_item(const Params& p, int l, int item, char* smem, int dry) {
  const int hp = item & 3, qb = (item >> 2) & 15, b = item >> 6;
  const int kvh = hp >> 1;
  u16* Ks = (u16*)smem;
  u16* Vt = (u16*)(smem + 256 * 72 * 2);
  float* invd = (float*)(smem + 256 * 72 * 2 + 64 * 264 * 2);
  const int tid = TIDX, lane = tid & 63, wave = tid >> 6, wq = wave & 3, l31 = lane & 31, h = lane >> 5;
  const int hq = hp * 2 + (wave >> 2);
  const size_t rowq0 = (size_t)b * SEQ + qb * 128;
  const long rowk0 = (long)rowq0 - 128;
  __syncthreads();
#pragma unroll
  for (int i = 0; i < 4; ++i) {
    const int cidx = tid + NTHR * i;
    const int key = cidx >> 3, cc = cidx & 7;
    uint4 v = {0u, 0u, 0u, 0u};
    if (qb > 0 || key >= 128) v = *(const uint4*)(p.PROJ + (size_t)(rowk0 + key) * PLD + C_AK + kvh * 64 + cc * 8);
    *(uint4*)(Ks + key * 72 + cc * 8) = v;
  }
#pragma unroll
  for (int i = 0; i < 4; ++i) {
    const int key = (tid & 63) + 64 * i;
    const int dc = tid >> 6;
    uint4 v = {0u, 0u, 0u, 0u};
    if (qb > 0 || key >= 128) v = *(const uint4*)(p.PROJ + (size_t)(rowk0 + key) * PLD + C_AV + kvh * 64 + dc * 8);
    const unsigned e[4] = {v.x, v.y, v.z, v.w};
#pragma unroll
    for (int j = 0; j < 4; ++j) {
      Vt[(dc * 8 + 2 * j) * 264 + key] = (u16)(e[j] & 0xffffu);
      Vt[(dc * 8 + 2 * j + 1) * 264 + key] = (u16)(e[j] >> 16);
    }
  }
  __syncthreads();
  const u16* qptr = p.PROJ + (rowq0 + wq * 32 + l31) * PLD + C_Q + hq * 64 + h * 8;
  bf16x8 qf[4];
#pragma unroll
  for (int ks = 0; ks < 4; ++ks) qf[ks] = *(const bf16x8*)(qptr + ks * 16);
  f32x16 sc[5];
#pragma unroll
  for (int i = 0; i < 5; ++i) {
#pragma unroll
    for (int r = 0; r < 16; ++r) sc[i][r] = 0.f;
    const u16* kp = Ks + ((wq + i) * 32 + l31) * 72 + h * 8;
#pragma unroll
    for (int ks = 0; ks < 4; ++ks) {
      const bf16x8 kf = *(const bf16x8*)(kp + ks * 16);
      sc[i] = MFMA(kf, qf[ks], sc[i]);
    }
  }
  const int qi = wq * 32 + l31;
  const float sink = p.sinks[l * 8 + hq];
  float m = sink;
#pragma unroll
  for (int i = 0; i < 5; ++i)
#pragma unroll
    for (int r = 0; r < 16; ++r) {
      const int j = (wq + i) * 32 + crow(r, h);
      const int rel = qi + 128 - j;
      const bool valid = (rel >= 0) && (rel < 128) && (qb > 0 || j >= 128);
      const float s = valid ? sc[i][r] * 0.125f : -INFINITY;
      sc[i][r] = s;
      m = fmaxf(m, s);
    }
  m = fmaxf(m, __shfl_xor(m, 32));
  float sum = 0.f;
#pragma unroll
  for (int i = 0; i < 5; ++i)
#pragma unroll
    for (int r = 0; r < 16; ++r) {
      const float pv = __expf(sc[i][r] - m);
      sc[i][r] = pv;
      sum += pv;
    }
  sum += __shfl_xor(sum, 32);
  const float denom = sum + __expf(sink - m);
  if (h == 0) invd[(wave >> 2) * 128 + qi] = 1.f / denom;
  f32x16 o[2];
#pragma unroll
  for (int db = 0; db < 2; ++db)
#pragma unroll
    for (int r = 0; r < 16; ++r) o[db][r] = 0.f;
#pragma unroll
  for (int i = 0; i < 5; ++i)
#pragma unroll
    for (int s2 = 0; s2 < 2; ++s2) {
      bf16x8 pa;
#pragma unroll
      for (int j = 0; j < 8; ++j) pa[j] = (short)f2bf(sc[i][8 * s2 + j]);
#pragma unroll
      for (int db = 0; db < 2; ++db) {
        const u16* vp = Vt + (db * 32 + l31) * 264 + (wq + i) * 32 + 16 * s2 + 4 * h;
        const s16x4 lo = *(const s16x4*)vp;
        const s16x4 hi = *(const s16x4*)(vp + 8);
        const bf16x8 vf = __builtin_shufflevector(lo, hi, 0, 1, 2, 3, 4, 5, 6, 7);
        o[db] = MFMA(pa, vf, o[db]);
      }
    }
  __syncthreads();
#pragma unroll
  for (int db = 0; db < 2; ++db)
#pragma unroll
    for (int r = 0; r < 16; ++r) {
      const int q = wq * 32 + crow(r, h);
      if (!dry) p.PROJ[(rowq0 + q) * PLD + C_Q + hq * 64 + db * 32 + l31] = f2bf(o[db][r] * invd[(wave >> 2) * 128 + q]);
    }
}

__device__ void phase_attn(const Params& p, int l, char* smem, int dry) {
  for (int it = BIDX; it < 1024; it += GDIM) attn_item(p, l, it, smem, dry);
}
__device__ void phase_mix(const Params& p, int l, char* smem, int dry) {
  for (int it = BIDX; it < 256; it += GDIM) {
    if (it < 128) rwkv_item(p, l, it, smem, dry);
    else ssd_item(p, l, it - 128, smem, dry);
  }
}

__device__ void phase_post(const Params& p, int l, char* smem) {
  cvt_T(p.w_gu + (size_t)l * DM * 2 * FH, 1024, 2 * FH, 0, 2 * FH, p.WguT, XLD, 0, 1, smem);
  cvt_T(p.w_down + (size_t)l * FH * DM, FH, 1024, 0, 1024, p.WdownT, FH, 0, 0, smem);
  const int lane = TIDX & 63;
  const int gw = BIDX * NWV + (TIDX >> 6), nw = GDIM * NWV;
  const float* nwp = p.ssm_norm_w + l * 512 + lane * 8;
  for (int row = gw; row < M_TOK; row += nw) {
    u16* pz = p.PROJ + (size_t)row * PLD + C_Z + lane * 8;
    const uint4 raw = *(const uint4*)pz;
    const unsigned e[4] = {raw.x, raw.y, raw.z, raw.w};
    float v[8];
    float ss = 0.f;
#pragma unroll
    for (int j = 0; j < 4; ++j) {
      v[2 * j] = bf2f((u16)(e[j] & 0xffffu));
      v[2 * j + 1] = bf2f((u16)(e[j] >> 16));
      ss += v[2 * j] * v[2 * j] + v[2 * j + 1] * v[2 * j + 1];
    }
#pragma unroll
    for (int o = 16; o > 0; o >>= 1) ss += __shfl_xor(ss, o);
    const float rstd = rsqrtf(ss * (1.f / 256.f) + 1e-6f);
    uint4 ov;
    ov.x = pack2(v[0] * rstd * nwp[0], v[1] * rstd * nwp[1]);
    ov.y = pack2(v[2] * rstd * nwp[2], v[3] * rstd * nwp[3]);
    ov.z = pack2(v[4] * rstd * nwp[4], v[5] * rstd * nwp[5]);
    ov.w = pack2(v[6] * rstd * nwp[6], v[7] * rstd * nwp[7]);
    *(uint4*)pz = ov;
  }
}

__device__ void phase_G2(const Params& p, int l, char* smem) {
  const int lane = TIDX & 63, wave = TIDX >> 6, wn = wave & 1, fq = lane >> 4;
  u32x4 ra[4], rw[2];
  bool pre = false;
  int mt, nt;
  bool have = next_tile(0, 128, 8, mt, nt);
  for (int k = 0; have; ++k) {
    int mt2 = 0, nt2 = 0;
    const bool have2 = next_tile(k + 1, 128, 8, mt2, nt2);
    const int m0 = mt * 256, n0 = nt * 128;
    f32x4 tot[4][4];
    zero_acc<2>(tot);
#pragma unroll 1
    for (int br = 0; br < 3; ++br) {
      const u16* Ab; int lda;
      if (br == 0) { Ab = p.GG + (size_t)m0 * 512; lda = 512; }
      else if (br == 1) { Ab = p.PROJ + (size_t)m0 * PLD + C_Z; lda = PLD; }
      else { Ab = p.PROJ + (size_t)m0 * PLD + C_Q; lda = PLD; }
      const u16* Wb = p.WbrT + ((size_t)br * 1024 + n0) * 512;
      f32x4 ac[4][4];
      zero_acc<2>(ac);
      gemm_core<2>(ac, p.XN + (size_t)m0 * XLD, XLD, p.WgT + ((size_t)br * 1024 + n0) * XLD, XLD, DM, smem, ra, rw, pre,
                   Ab, lda, Wb, 512);
      unsigned sg[4][4][2];
      const float* gb = p.gate_b + l * 3072 + br * 1024 + n0 + wn * 64 + fq * 4;
#pragma unroll
      for (int nb = 0; nb < 4; ++nb) {
        const f32x4 bias = *(const f32x4*)(gb + nb * 16);
#pragma unroll
        for (int mb = 0; mb < 4; ++mb) {
          sg[nb][mb][0] = cvt_pk_bf16(sigmoidf_(ac[nb][mb][0] + bias[0]), sigmoidf_(ac[nb][mb][1] + bias[1]));
          sg[nb][mb][1] = cvt_pk_bf16(sigmoidf_(ac[nb][mb][2] + bias[2]), sigmoidf_(ac[nb][mb][3] + bias[3]));
        }
      }
      zero_acc<2>(ac);
      const bool more = br < 2 || have2;
      const int m0n = br < 2 ? m0 : mt2 * 256, n0n = br < 2 ? n0 : nt2 * 128, brn = br < 2 ? br + 1 : 0;
      gemm_core<2>(ac, Ab, lda, Wb, 512, 512, smem, ra, rw, true,
                   more ? p.XN + (size_t)m0n * XLD : nullptr, XLD, p.WgT + ((size_t)brn * 1024 + n0n) * XLD, XLD);
      pre = more;
#pragma unroll
      for (int nb = 0; nb < 4; ++nb)
#pragma unroll
        for (int mb = 0; mb < 4; ++mb) {
          tot[nb][mb][0] += __uint_as_float(sg[nb][mb][0] << 16) * ac[nb][mb][0];
          tot[nb][mb][1] += __uint_as_float(sg[nb][mb][0] & 0xffff0000u) * ac[nb][mb][1];
          tot[nb][mb][2] += __uint_as_float(sg[nb][mb][1] << 16) * ac[nb][mb][2];
          tot[nb][mb][3] += __uint_as_float(sg[nb][mb][1] & 0xffff0000u) * ac[nb][mb][3];
        }
    }
    u16* dst = p.MERGED + (size_t)m0 * DM + n0;
    epilogue_bf16<2>(tot, smem, dst, DM, [&](int, int, f32x4 v) { return v; });
    mt = mt2; nt = nt2; have = have2;
  }
}

__device__ void phase_resid(const Params& p, const u16* A, int K, const u16* W, int ldw, char* smem, int dry) {
  for (int k = 0;; ++k) {
    int mt, nt;
    if (!next_tile(k, 128, 4, mt, nt)) break;
    f32x4 acc[8][4];
    zero_acc<4>(acc);
    gemm_core<4>(acc, A + (size_t)mt * 256 * K, K, W + (size_t)nt * 256 * ldw, ldw, K, smem);
    float* dst = p.out + (size_t)mt * 256 * DM + nt * 256;
    epilogue<4>(acc, smem, [&](int row, int col, f32x4 v) {
      f32x4* px = (f32x4*)(dst + (size_t)row * DM + col);
      f32x4 x = *px;
      x[0] += v[0]; x[1] += v[1]; x[2] += v[2]; x[3] += v[3];
      if (!dry) *px = x;
    });
  }
}

__device__ void phase_G4(const Params& p, char* smem) {
  u32x4 ra[4], rw[4];
  bool pre = false;
  int mt, nt;
  bool have = next_tile(0, 128, 22, mt, nt);
  for (int k = 0; have; ++k) {
    int mt2 = 0, nt2 = 0;
    const bool have2 = next_tile(k + 1, 128, 22, mt2, nt2);
    f32x4 acc[8][4];
    zero_acc<4>(acc);
    gemm_core<4>(acc, p.XN + (size_t)mt * 256 * XLD, XLD, p.WguT + (size_t)nt * 256 * XLD, XLD, DM, smem, ra, rw, pre,
                 have2 ? p.XN + (size_t)mt2 * 256 * XLD : nullptr, XLD, p.WguT + (size_t)nt2 * 256 * XLD, XLD);
    pre = have2;
    f32x4 hv[4][4];
#pragma unroll
    for (int pb = 0; pb < 4; ++pb) {
      const int nbg = (pb >> 1) * 4 + (pb & 1);
#pragma unroll
      for (int mb = 0; mb < 4; ++mb)
#pragma unroll
        for (int j = 0; j < 4; ++j) hv[pb][mb][j] = siluf_(acc[nbg][mb][j]) * acc[nbg + 2][mb][j];
    }
    u16* dst = p.H + (size_t)mt * 256 * FH + nt * 128;
    epilogue_bf16<2>(hv, smem, dst, FH, [&](int, int, f32x4 v) { return v; });
    mt = mt2; nt = nt2; have = have2;
  }
}

__device__ void phase_final(const Params& p) { rmsnorm_rows(p.out, p.norm_final, nullptr, p.out); }

DI void grid_barrier(unsigned* bar, unsigned target) {
  __syncthreads();
  if (TIDX == 0) {
    __threadfence();
    __hip_atomic_fetch_add(bar, 1u, __ATOMIC_RELAXED, __HIP_MEMORY_SCOPE_AGENT);
    while (__hip_atomic_load(bar, __ATOMIC_RELAXED, __HIP_MEMORY_SCOPE_AGENT) < target) __builtin_amdgcn_s_sleep(4);
    __threadfence();
  }
  __syncthreads();
}

#define XB_TMO      128
#define XB_XCNT(j)  (256  + 64 * (j))
#define XB_XSUB(j)  (1280 + 64 * (j))
#define XB_XGEN(j)  (2304 + 64 * (j))
#define XB_TOP      3328
#define XB_TOPGEN   3392
#define XCD_BAR_WORDS 3456
#define XB_SPIN_CAP (1u << 20)
#define LAS __attribute__((address_space(3)))
DI unsigned xb_ld(unsigned* p) { return __hip_atomic_load(p, __ATOMIC_RELAXED, __HIP_MEMORY_SCOPE_AGENT); }
DI unsigned xb_add(unsigned* p, unsigned v) { return __hip_atomic_fetch_add(p, v, __ATOMIC_RELAXED, __HIP_MEMORY_SCOPE_AGENT); }
DI unsigned xb_xcc_id() { return (unsigned)__builtin_amdgcn_s_getreg((3 << 11) | 20) & 0xFu; }
#define XB_SPIN(cond, bar) do { unsigned _sp = 0; while (cond) { __builtin_amdgcn_s_sleep(1); \
    if ((++_sp & 255u) == 0u) { if (xb_ld(&(bar)[XB_TMO])) break; if (_sp > XB_SPIN_CAP) { atomicAdd(&(bar)[XB_TMO], 1u); break; } } } } while (0)
DI void xcd_barrier_post(unsigned* bar) {
  if (threadIdx.x == 0) (void)xb_add(&bar[XB_XCNT(xb_xcc_id())], 1u);
}
DI void xcd_barrier_complete(unsigned* bar, unsigned x, unsigned& nloc, unsigned& nx) {
  const unsigned G = gridDim.x;
  unsigned sum, cnt, mine, sp = 0u;
  for (;;) {
    sum = 0u; cnt = 0u; mine = 0u;
#pragma unroll
    for (unsigned j = 0; j < 16; ++j) { const unsigned c = xb_ld(&bar[XB_XCNT(j)]); sum += c; cnt += (c > 0u) ? 1u : 0u; mine = (j == x) ? c : mine; }
    if (sum == G) break;
    __builtin_amdgcn_s_sleep(1);
    if ((++sp & 255u) == 0u) { if (xb_ld(&bar[XB_TMO])) break; if (sp > XB_SPIN_CAP) { atomicAdd(&bar[XB_TMO], 1u); break; } }
  }
  nloc = mine > 0u ? mine : 1u; nx = cnt > 0u ? cnt : 1u;
}
DI void xcd_barrier(unsigned* bar, volatile LAS unsigned* st) {
  asm volatile("s_waitcnt vmcnt(0)" ::: "memory");
  __syncthreads();
  if (threadIdx.x == 0) {
    __builtin_amdgcn_s_waitcnt(0);
    const unsigned x = xb_xcc_id();
    unsigned nloc = st[0], nx = st[1];
    if (nloc == 0u) { xcd_barrier_complete(bar, x, nloc, nx); st[0] = nloc; st[1] = nx; }
    const unsigned old = xb_add(&bar[XB_XSUB(x)], 1u);
    const unsigned gen = old / nloc;
    if (old + 1u == (gen + 1u) * nloc) {
      __builtin_amdgcn_fence(__ATOMIC_RELEASE, "agent");
      asm volatile("s_waitcnt vmcnt(0)" ::: "memory");
      const unsigned og = xb_add(&bar[XB_TOP], 1u);
      const unsigned tg = og / nx;
      if (og + 1u == (tg + 1u) * nx) xb_add(&bar[XB_TOPGEN], 1u);
      else XB_SPIN(xb_ld(&bar[XB_TOPGEN]) == tg, bar);
      __builtin_amdgcn_fence(__ATOMIC_ACQUIRE, "agent");
      xb_add(&bar[XB_XGEN(x)], 1u);
      asm volatile("s_waitcnt vmcnt(0)" ::: "memory");
    } else {
      XB_SPIN(xb_ld(&bar[XB_XGEN(x)]) == gen, bar);
      __builtin_amdgcn_fence(__ATOMIC_ACQUIRE, "agent");
      asm volatile("s_waitcnt vmcnt(0)" ::: "memory");
    }
  }
  __syncthreads();
}

constexpr int NPH = 12;
DI void run_phase(const Params& p, int l, int ph, char* smem, int dry = 0) {
  asm volatile("" : "+s"(l));
  switch (ph) {
    case 0: phase_A(p, l, smem); break;
    case 1: phase_G1(p, smem); break;
    case 2: phase_pre(p, l); break;
    case 3: phase_prep(p, l, smem); break;
    case 4: phase_mix(p, l, smem, dry); break;
    case 11: phase_attn(p, l, smem, dry); break;
    case 5: phase_post(p, l, smem); break;
    case 6: phase_G2(p, l, smem); break;
    case 7: phase_resid(p, p.MERGED, DM, p.WoutT, XLD, smem, dry); break;
    case 8: rmsnorm_rows(p.out, p.norm_ffn + l * DM, p.XN, nullptr); break;
    case 9: phase_G4(p, smem); break;
    case 10: phase_resid(p, p.H, FH, p.WdownT, FH, smem, dry); break;
    default: break;
  }
}

#if MULTI
template <int PH>
__global__ void __launch_bounds__(NTHR) k_phase(Params p, int l) {
  __shared__ __attribute__((aligned(16))) char smem[SMEM_BYTES];
  if (PH < NPH) run_phase(p, l, PH, smem);
  else phase_final(p);
}
#else
__global__ void __launch_bounds__(NTHR) k_mega(Params p) {
  __shared__ __attribute__((aligned(16))) char smem[SMEM_BYTES];
  cg::grid_group grid = cg::this_grid();
  __shared__ uint4 xb_words;
  if (threadIdx.x == 0) xb_words = make_uint4(0u, 0u, 0u, 0u);
  __syncthreads();
  unsigned* bar = (unsigned*)p.ctr;
  if (blockIdx.x == 0) for (int i = threadIdx.x; i < XCD_BAR_WORDS; i += NTHR) bar[i] = 0u;
  for (int l = 0; l < 2; ++l) {
#pragma unroll 1
    for (int i = 0; i < NPH; ++i) {
      const int ph = i < 4 ? i : (i == 4 ? 11 : i - 1);
      run_phase(p, l, ph, smem);
      if (l == 0 && i == 0) { grid.sync(); xcd_barrier_post(bar); }
      else xcd_barrier(bar, (volatile LAS unsigned*)&xb_words);
    }
  }
  phase_final(p);
}
#endif

extern "C" void kernel_launch(void* const* d_in, const int* in_sizes, int n_in, void* d_out, int out_size, void* d_ws, size_t ws_size,
                              hipStream_t stream) {
  Params p{};
  const float** pf = (const float**)&p;
  for (int i = 0; i < 34; ++i) pf[i] = (const float*)d_in[i];
  p.out = (float*)d_out;
  char* ws = (char*)d_ws;
  size_t off = 0;
  auto take = [&](size_t bytes) { char* r = ws + off; off += (bytes + 255) & ~(size_t)255; return r; };
  p.ctr = (int*)take(16384);
  p.WinT = (u16*)take((size_t)PLD * XLD * 2);
  p.WgT = (u16*)take((size_t)3072 * XLD * 2);
  p.WbrT = (u16*)take((size_t)3 * 1024 * 512 * 2);
  p.WoutT = (u16*)take((size_t)1024 * XLD * 2);
  p.w2T = (u16*)take(512 * 64 * 2);
  p.a2T = (u16*)take(512 * 64 * 2);
  p.g2T = (u16*)take(512 * 192 * 2);
  p.v2T = (u16*)take(512 * 64 * 2);
  char* shared = take((size_t)M_TOK * LALD * 2);
  p.LA = (u16*)shared;
  p.WguT = (u16*)shared;
  p.WdownT = (u16*)(shared + (size_t)2 * FH * XLD * 2);
  p.XN = (u16*)take((size_t)M_TOK * XLD * 2);
  p.PROJ = (u16*)take((size_t)M_TOK * PLD * 2);
  p.H = p.PROJ;
  p.VF = (u16*)take((size_t)M_TOK * 512 * 2);
  p.AA = (u16*)take((size_t)M_TOK * 512 * 2);
  p.WR = (u16*)take((size_t)M_TOK * 512 * 2);
  p.GG = (u16*)take((size_t)M_TOK * 512 * 2);
  p.MERGED = p.AA;
  if (off > ws_size || n_in != 34) { fprintf(stderr, "kernel_launch: workspace too small (%zu needed, %zu given) or n_in %d\n", off, ws_size, n_in); return; }
#if MULTI
#define LP(PH) hipLaunchKernelGGL(k_phase<PH>, dim3(256), dim3(NTHR), 0, stream, p, l)
  for (int l = 0; l < 2; ++l) { LP(0); LP(1); LP(2); LP(3); LP(11); LP(4); LP(5); LP(6); LP(7); LP(8); LP(9); LP(10); }
  { int l = 0; LP(12); }
#else
  static int grid = 0;
  if (!grid) {
    int dev = 0, cus = 0, per_cu = 0;
    hipGetDevice(&dev);
    hipDeviceGetAttribute(&cus, hipDeviceAttributeMultiprocessorCount, dev);
    (void)hipOccupancyMaxActiveBlocksPerMultiprocessor(&per_cu, k_mega, NTHR, 0);
    if (per_cu < 1) per_cu = 1;
    if (per_cu > 1) per_cu = 1;
    grid = cus * per_cu;
  }
  void* args[] = {&p};
  hipError_t e = hipLaunchCooperativeKernel((void*)k_mega, dim3(grid), dim3(NTHR), args, 0, stream);
  if (e != hipSuccess) fprintf(stderr, "cooperative launch failed: %s (grid %d)\n", hipGetErrorString(e), grid);
#endif
}
```

```cpp
#include <hip/hip_runtime.h>
#include <hip/hip_cooperative_groups.h>
#include <cstdio>
#include <cstdint>
namespace cg = cooperative_groups;

#ifndef MULTI
#define MULTI 0
#endif

typedef unsigned short u16;
typedef short bf16x8 __attribute__((ext_vector_type(8)));
typedef short s16x4 __attribute__((ext_vector_type(4)));
typedef float f32x16 __attribute__((ext_vector_type(16)));
typedef float f32x4 __attribute__((ext_vector_type(4)));
typedef float f32x2 __attribute__((ext_vector_type(2)));
typedef unsigned u32x4 __attribute__((ext_vector_type(4)));

#define DI __device__ __forceinline__
#define MFMA(a, b, c) __builtin_amdgcn_mfma_f32_32x32x16_bf16((a), (b), (c), 0, 0, 0)
#define MFMA16(a, b, c) __builtin_amdgcn_mfma_f32_16x16x32_bf16((a), (b), (c), 0, 0, 0)

constexpr int M_TOK = 32768;
constexpr int SEQ = 2048;
constexpr int DM = 1024;
constexpr int PLD = 4224;
constexpr int C_R = 0, C_K = 512, C_V = 1024, C_LW = 1536, C_LA = 1600, C_LG = 1664;
constexpr int C_LV = 1824, C_Z = 1856, C_XBC = 2368, C_DT = 3392, C_Q = 3456, C_AK = 3968, C_AV = 4096;
constexpr int LALD = 384;
constexpr int XLD = 1088;
constexpr int FH = 2816;
constexpr int SMEM_BYTES = 147456;
constexpr int NTHR = 512;
constexpr int NWV = 8;

struct Params {
  const float* x; const float* norm_mix; const float* w_in; const float* rw_mu; const float* rw_w0; const float* rw_w2;
  const float* rw_a0; const float* rw_a2; const float* rw_g2; const float* rw_k_k; const float* rw_k_a; const float* rw_r_k;
  const float* rw_gn_w; const float* rw_gn_b; const float* vres_down; const float* vres_mu; const float* vres_v0; const float* vres_v2;
  const float* conv_w; const float* conv_b; const float* dt_bias; const float* a_log; const float* ssm_d; const float* ssm_norm_w;
  const float* sinks; const float* gate_b; const float* w_br_rw; const float* w_br_ssm; const float* w_br_att; const float* w_out;
  const float* norm_ffn; const float* w_gu; const float* w_down; const float* norm_final;
  float* out;
  u16 *WinT, *WgT, *WbrT, *WoutT, *w2T, *a2T, *g2T, *v2T, *WguT, *WdownT, *LA, *XN, *PROJ, *VF, *AA, *WR, *GG, *MERGED, *H;
  int* ctr;
};

DI int tidx_() { int t = (int)__builtin_amdgcn_workitem_id_x(); asm volatile("" : "+v"(t)); return t; }
DI int bidx_() { int t = (int)__builtin_amdgcn_workgroup_id_x(); asm volatile("" : "+s"(t)); return t; }
DI int gdim_() { int t = (int)gridDim.x; asm volatile("" : "+s"(t)); return t; }
#define TIDX tidx_()
#define BIDX bidx_()
#define GDIM gdim_()

DI float bf2f(u16 v) { return __uint_as_float(((unsigned)v) << 16); }
DI u16 f2bf(float f) { unsigned u = __float_as_uint(f); u += 0x7fffu + ((u >> 16) & 1u); return (u16)(u >> 16); }
DI unsigned pack2(float a, float b) { return (unsigned)f2bf(a) | ((unsigned)f2bf(b) << 16); }
DI unsigned cvt_pk_bf16(float a, float b) { unsigned r; asm volatile("s_nop 4\n\tv_cvt_pk_bf16_f32 %0, %1, %2\n\ts_nop 1" : "=v"(r) : "v"(a), "v"(b)); return r; }
DI float sigmoidf_(float x) { return __builtin_amdgcn_rcpf(1.f + __expf(-x)); }
DI float siluf_(float x) { return x * sigmoidf_(x); }
DI float tanhf_(float x) { return 1.f - 2.f * __builtin_amdgcn_rcpf(1.f + __expf(2.f * x)); }
DI float softplusf_(float z) { return z > 20.f ? z : __logf(1.f + __expf(z)); }
DI int crow(int r, int h) { return (r & 3) + 8 * (r >> 2) + 4 * h; }
DI float dppf(float x, const int ctrl_sel) {
  int xi = __float_as_int(x);
  int r;
  if (ctrl_sel == 0) r = __builtin_amdgcn_update_dpp(0, xi, 0xB1, 0xF, 0xF, true);
  else if (ctrl_sel == 1) r = __builtin_amdgcn_update_dpp(0, xi, 0x4E, 0xF, 0xF, true);
  else r = __builtin_amdgcn_update_dpp(0, xi, 0x141, 0xF, 0xF, true);
  return __int_as_float(r);
}
DI float red8(float x) {
  x += dppf(x, 0);
  x += dppf(x, 1);
  x += dppf(x, 2);
  return x;
}
DI float red4(float x) {
  x += dppf(x, 0);
  x += dppf(x, 1);
  return x;
}
DI float red16(float x) {
  x = red8(x);
  x += __int_as_float(__builtin_amdgcn_update_dpp(0, __float_as_int(x), 0x140, 0xF, 0xF, true));
  return x;
}
DI float wave_sum(float v) {
  v = red8(v);
  v += __int_as_float(__builtin_amdgcn_update_dpp(0, __float_as_int(v), 0x140, 0xF, 0xF, true));
  const float r0 = __int_as_float(__builtin_amdgcn_readlane(__float_as_int(v), 0));
  const float r1 = __int_as_float(__builtin_amdgcn_readlane(__float_as_int(v), 16));
  const float r2 = __int_as_float(__builtin_amdgcn_readlane(__float_as_int(v), 32));
  const float r3 = __int_as_float(__builtin_amdgcn_readlane(__float_as_int(v), 48));
  return (r0 + r1) + (r2 + r3);
}

__device__ void cvt_T(const float* __restrict__ src, int K, int ld, int c0, int ncols, u16* __restrict__ dst, int dld, int r0,
                      int mode, char* smem) {
  float* tl = (float*)smem;
  const int ct = (ncols + 31) >> 5, kt = (K + 63) >> 6;
  const int tid = TIDX;
  const int nt = ct * kt, gd = GDIM;
  const int rk = tid >> 5, rc = tid & 31;
  float v[4];
  auto LOADT = [&](int t) {
    const int cb = (t % ct) * 32, kb = (t / ct) * 64;
#pragma unroll
    for (int i = 0; i < 4; ++i) {
      const int k = rk + 16 * i;
      v[i] = 0.f;
      if (cb + rc < ncols && kb + k < K) v[i] = src[(size_t)(kb + k) * ld + c0 + cb + rc];
    }
  };
  int t = BIDX;
  if (t < nt) LOADT(t);
  for (; t < nt; t += gd) {
    const int cb = (t % ct) * 32, kb = (t / ct) * 64;
    __syncthreads();
#pragma unroll
    for (int i = 0; i < 4; ++i) tl[rc * 65 + rk + 16 * i] = v[i];
    __syncthreads();
    if (t + gd < nt) LOADT(t + gd);
    {
      const int c = tid >> 4, kc = tid & 15;
      if (cb + c < ncols) {
        int drow;
        if (mode == 0) drow = r0 + cb + c;
        else { const int ty = cb >= FH ? 1 : 0; const int j0 = cb - ty * FH; drow = (j0 >> 5) * 64 + ty * 32 + c; }
        const float* sp = tl + c * 65 + kc * 4;
        uint2 o; o.x = pack2(sp[0], sp[1]); o.y = pack2(sp[2], sp[3]);
        *(uint2*)(dst + (size_t)drow * dld + kb + kc * 4) = o;
      }
    }
  }
  __syncthreads();
}

template <int NI>
DI void gemm_core(f32x4 (&acc)[2 * NI][4], const u16* __restrict__ A, int lda, const u16* __restrict__ W, int ldw, int K, char* smem,
                  u32x4 (&ra)[4], u32x4 (&rw)[NI], bool pre, const u16* nA, int nlda, const u16* nW, int nldw) {
  constexpr int A_ELEMS = 256 * 64;
  constexpr int W_ELEMS = 64 * NI * 64;
  u16* As = (u16*)smem;
  u16* Ws = As + 2 * A_ELEMS;
  const int tid = TIDX, lane = tid & 63, wave = tid >> 6;
  const int wm = wave >> 1, wn = wave & 1, fr = lane & 15, fq = lane >> 4;
  const int lr = tid >> 3, lc = tid & 7;
  unsigned opq = 0;
  asm volatile("" : "+v"(opq));
  const u16* ag = A + (size_t)lr * lda + lc * 8 + opq;
  const u16* wg = W + (size_t)lr * ldw + lc * 8 + opq;
  const int sw_st = (lc ^ ((lr >> 1) & 7)) * 8;
  auto GLOAD = [&](int k0) {
#pragma unroll
    for (int i = 0; i < 4; ++i) ra[i] = *(const u32x4*)(ag + (size_t)(64 * i) * lda + k0);
#pragma unroll
    for (int i = 0; i < NI; ++i) rw[i] = *(const u32x4*)(wg + (size_t)(64 * i) * ldw + k0);
  };
  auto GLOADNEXT = [&]() {
    const u16* ag2 = nA + (size_t)lr * nlda + lc * 8 + opq;
    const u16* wg2 = nW + (size_t)lr * nldw + lc * 8 + opq;
#pragma unroll
    for (int i = 0; i < 4; ++i) ra[i] = *(const u32x4*)(ag2 + (size_t)(64 * i) * nlda);
#pragma unroll
    for (int i = 0; i < NI; ++i) rw[i] = *(const u32x4*)(wg2 + (size_t)(64 * i) * nldw);
  };
  auto SSTORE = [&](int buf) {
#pragma unroll
    for (int i = 0; i < 4; ++i) *(u32x4*)(As + buf * A_ELEMS + (lr + 64 * i) * 64 + sw_st) = ra[i];
#pragma unroll
    for (int i = 0; i < NI; ++i) *(u32x4*)(Ws + buf * W_ELEMS + (lr + 64 * i) * 64 + sw_st) = rw[i];
  };
  const int swz = fr >> 1;
  const int off0 = ((0 + fq) ^ swz) * 8, off1 = ((4 + fq) ^ swz) * 8;
  const int KT = K >> 6;
  if (!pre) GLOAD(0);
  SSTORE(0);
  if (KT > 1) GLOAD(64);
  else if (nA) GLOADNEXT();
  __syncthreads();
#pragma unroll 1
  for (int kt = 0; kt < KT; ++kt) {
    const int buf = kt & 1;
    if (kt + 1 < KT) {
      SSTORE(buf ^ 1);
      if (kt + 2 < KT) GLOAD((kt + 2) * 64);
      else if (nA) GLOADNEXT();
    }
    const u16* as = As + buf * A_ELEMS + (wm * 64 + fr) * 64;
    const u16* ws = Ws + buf * W_ELEMS + (wn * 32 * NI + fr) * 64;
#pragma unroll
    for (int ks = 0; ks < 2; ++ks) {
      const int off = ks ? off1 : off0;
      bf16x8 wf[2 * NI], af[4];
#pragma unroll
      for (int nb = 0; nb < 2 * NI; ++nb) wf[nb] = *(const bf16x8*)(ws + nb * 16 * 64 + off);
#pragma unroll
      for (int mb = 0; mb < 4; ++mb) af[mb] = *(const bf16x8*)(as + mb * 16 * 64 + off);
#pragma unroll
      for (int nb = 0; nb < 2 * NI; ++nb)
#pragma unroll
        for (int mb = 0; mb < 4; ++mb) acc[nb][mb] = MFMA16(wf[nb], af[mb], acc[nb][mb]);
    }
    __syncthreads();
  }
}
template <int NI>
DI void gemm_core(f32x4 (&acc)[2 * NI][4], const u16* __restrict__ A, int lda, const u16* __restrict__ W, int ldw, int K, char* smem) {
  u32x4 ra[4], rw[NI];
  gemm_core<NI>(acc, A, lda, W, ldw, K, smem, ra, rw, false, nullptr, 0, nullptr, 0);
}

template <int NI>
DI void zero_acc(f32x4 (&acc)[2 * NI][4]) {
#pragma unroll
  for (int nb = 0; nb < 2 * NI; ++nb)
#pragma unroll
    for (int mb = 0; mb < 4; ++mb) acc[nb][mb] = f32x4{0.f, 0.f, 0.f, 0.f};
}

template <int NI, typename F>
DI void epilogue(f32x4 (&acc)[2 * NI][4], char* smem, F epi) {
  constexpr int SLD = 132;
  float* st = (float*)smem;
  const int tid = TIDX, lane = tid & 63, wave = tid >> 6;
  const int wm = wave >> 1, wn = wave & 1, fr = lane & 15, fq = lane >> 4;
#pragma unroll
  for (int q = 0; q < NI / 2; ++q) {
#pragma unroll
    for (int nn = 0; nn < 4; ++nn)
#pragma unroll
      for (int mb = 0; mb < 4; ++mb)
        *(f32x4*)(st + (wm * 64 + mb * 16 + fr) * SLD + wn * 64 + nn * 16 + fq * 4) = acc[4 * q + nn][mb];
    __syncthreads();
    for (int idx = tid; idx < 256 * 32; idx += NTHR) {
      const int row = idx >> 5, sc = (idx & 31) * 4;
      f32x4 v = *(const f32x4*)(st + row * SLD + sc);
      epi(row, (sc >> 6) * (32 * NI) + q * 64 + (sc & 63), v);
    }
    __syncthreads();
  }
}

DI bool next_tile(int k, int MT, int NT, int& mt, int& nt) {
  const int bid = BIDX, gd = GDIM;
  int tl = (gd == 256) ? k * 256 + (bid & 7) * 32 + (bid >> 3) : k * gd + bid;
  if (tl >= MT * NT) return false;
  const int band = tl / (MT * 8);
  const int w = (NT - band * 8) < 8 ? (NT - band * 8) : 8;
  const int within = tl - band * MT * 8;
  mt = within / w;
  nt = band * 8 + within % w;
  return true;
}

DI void lds_barrier() { asm volatile("s_waitcnt lgkmcnt(0)\n\ts_barrier" ::: "memory"); }

template <int NI, bool NT = false, typename F>
DI void epilogue_bf16(f32x4 (&acc)[2 * NI][4], char* smem, u16* dst, int ld, F tr) {
  constexpr int SLD = 264;
  u16* st = (u16*)smem;
  const int tid = TIDX, lane = tid & 63, wave = tid >> 6;
  const int wm = wave >> 1, wn = wave & 1, fr = lane & 15, fq = lane >> 4;
#pragma unroll
  for (int nb = 0; nb < 2 * NI; ++nb)
#pragma unroll
    for (int mb = 0; mb < 4; ++mb) {
      const int row = wm * 64 + mb * 16 + fr, col = wn * 32 * NI + nb * 16 + fq * 4;
      const f32x4 v = tr(row, col, acc[nb][mb]);
      uint2 o; o.x = pack2(v[0], v[1]); o.y = pack2(v[2], v[3]);
      *(uint2*)(st + row * SLD + col) = o;
    }
  lds_barrier();
  constexpr int CH = 8 * NI;
  for (int idx = tid; idx < 256 * CH; idx += NTHR) {
    const int row = idx / CH, ch = idx % CH;
    const u32x4 v = *(const u32x4*)(st + row * SLD + ch * 8);
    if (NT) __builtin_nontemporal_store(v, (u32x4*)(dst + (size_t)row * ld + ch * 8));
    else *(u32x4*)(dst + (size_t)row * ld + ch * 8) = v;
  }
  lds_barrier();
}

DI void store_bf4(u16* dst, f32x4 v) {
  uint2 o; o.x = pack2(v[0], v[1]); o.y = pack2(v[2], v[3]);
  *(uint2*)dst = o;
}

__device__ void rmsnorm_rows(const float* xin, const float* __restrict__ w, u16* xn, float* copy_to) {
  const int lane = TIDX & 63;
  const int gw = BIDX * NWV + (TIDX >> 6), nw = GDIM * NWV;
  for (int row = gw; row < M_TOK; row += nw) {
    const float* xr = xin + (size_t)row * DM;
    f32x4 v[4];
    float ss = 0.f;
#pragma unroll
    for (int i = 0; i < 4; ++i) {
      v[i] = *(const f32x4*)(xr + i * 256 + lane * 4);
      ss += v[i][0] * v[i][0] + v[i][1] * v[i][1] + v[i][2] * v[i][2] + v[i][3] * v[i][3];
    }
    ss = wave_sum(ss);
    const float rstd = rsqrtf(ss * (1.f / DM) + 1e-6f);
#pragma unroll
    for (int i = 0; i < 4; ++i) {
      const f32x4 ww = *(const f32x4*)(w + i * 256 + lane * 4);
      f32x4 o = {v[i][0] * rstd * ww[0], v[i][1] * rstd * ww[1], v[i][2] * rstd * ww[2], v[i][3] * rstd * ww[3]};
      if (xn) store_bf4(xn + (size_t)row * XLD + i * 256 + lane * 4, o);
      else *(f32x4*)(copy_to + (size_t)row * DM + i * 256 + lane * 4) = o;
      if (xn && copy_to) *(f32x4*)(copy_to + (size_t)row * DM + i * 256 + lane * 4) = v[i];
    }
  }
}

__device__ void phase_A(const Params& p, int l, char* smem) {
  const float* win = p.w_in + (size_t)l * DM * 7208;
  cvt_T(win, 1024, 7208, 0, 1824, p.WinT, XLD, 0, 0, smem);
  cvt_T(win, 1024, 7208, 1824, 1544, p.WinT, XLD, C_Z, 0, smem);
  cvt_T(win, 1024, 7208, 3368, 768, p.WinT, XLD, C_Q, 0, smem);
  if (l == 1) cvt_T(p.vres_down, 1024, 32, 0, 32, p.WinT, XLD, C_LV, 0, smem);
  cvt_T(win, 1024, 7208, 4136, 3072, p.WgT, XLD, 0, 0, smem);
  cvt_T(p.w_br_rw + (size_t)l * 512 * 1024, 512, 1024, 0, 1024, p.WbrT, 512, 0, 0, smem);
  cvt_T(p.w_br_ssm + (size_t)l * 512 * 1024, 512, 1024, 0, 1024, p.WbrT + 1024 * 512, 512, 0, 0, smem);
  cvt_T(p.w_br_att + (size_t)l * 512 * 1024, 512, 1024, 0, 1024, p.WbrT + 2 * 1024 * 512, 512, 0, 0, smem);
  cvt_T(p.w_out + (size_t)l * 1024 * 1024, 1024, 1024, 0, 1024, p.WoutT, XLD, 0, 0, smem);
  cvt_T(p.rw_w2 + (size_t)l * 64 * 512, 64, 512, 0, 512, p.w2T, 64, 0, 0, smem);
  cvt_T(p.rw_a2 + (size_t)l * 64 * 512, 64, 512, 0, 512, p.a2T, 64, 0, 0, smem);
  cvt_T(p.rw_g2 + (size_t)l * 160 * 512, 160, 512, 0, 512, p.g2T, 192, 0, 0, smem);
  if (l == 1) cvt_T(p.vres_v2, 32, 512, 0, 512, p.v2T, 64, 0, 0, smem);
  if (l == 0) rmsnorm_rows(p.x, p.norm_mix, p.XN, p.out);
  else rmsnorm_rows(p.out, p.norm_mix + DM, p.XN, nullptr);
}

__device__ void phase_G1(const Params& p, char* smem) {
  u32x4 ra[4], rw[4];
  bool pre = false;
  int mt, j;
  bool have = next_tile(0, 128, 17, mt, j);
  for (int k = 0; have; ++k) {
    int mt2 = 0, j2 = 0;
    const bool have2 = next_tile(k + 1, 128, 17, mt2, j2);
    const u16* A = p.XN + (size_t)mt * 256 * XLD;
    u16* dst = p.PROJ + (size_t)mt * 256 * PLD + j * 256;
    if (j < 16) {
      const bool nx = have2 && j2 < 16;
      f32x4 acc[8][4];
      zero_acc<4>(acc);
      gemm_core<4>(acc, A, XLD, p.WinT + (size_t)j * 256 * XLD, XLD, DM, smem, ra, rw, pre,
                   nx ? p.XN + (size_t)mt2 * 256 * XLD : nullptr, XLD, p.WinT + (size_t)j2 * 256 * XLD, XLD);
      pre = nx;
      epilogue_bf16<4, true>(acc, smem, dst, PLD, [&](int, int, f32x4 v) { return v; });
    } else {
      f32x4 acc[4][4];
      zero_acc<2>(acc);
      gemm_core<2>(acc, A, XLD, p.WinT + (size_t)j * 256 * XLD, XLD, DM, smem);
      pre = false;
      epilogue_bf16<2, true>(acc, smem, dst, PLD, [&](int, int, f32x4 v) { return v; });
    }
    mt = mt2; j = j2; have = have2;
  }
}

__device__ void phase_pre(const Params& p, int l) {
  const int lane = TIDX & 63;
  const int gw = BIDX * NWV + (TIDX >> 6), nw = GDIM * NWV;
  const float* mu = p.rw_mu + l * 1824;
  for (int row = gw; row < M_TOK; row += nw) {
    const bool hp = (row & (SEQ - 1)) != 0;
    const u16* pr = p.PROJ + (size_t)row * PLD;
    const u16* pp = pr - PLD;
    u16* la = p.LA + (size_t)row * LALD;
    auto mix = [&](int colp, float m) {
      const float a = bf2f(pr[colp]);
      const float b = hp ? bf2f(pp[colp]) : 0.f;
      return a + (b - a) * m;
    };
    la[lane] = f2bf(tanhf_(mix(C_LW + lane, mu[C_LW + lane])));
    la[64 + lane] = f2bf(mix(C_LA + lane, mu[C_LA + lane]));
    la[128 + lane] = f2bf(sigmoidf_(mix(C_LG + lane, mu[C_LG + lane])));
    la[192 + lane] = f2bf(sigmoidf_(mix(C_LG + 64 + lane, mu[C_LG + 64 + lane])));
    u16 e4 = 0;
    if (lane < 32) e4 = f2bf(sigmoidf_(mix(C_LG + 128 + lane, mu[C_LG + 128 + lane])));
    la[256 + lane] = e4;
    u16 e5 = 0;
    if (l == 1 && lane < 32) e5 = f2bf(mix(C_LV + lane, p.vres_mu[lane]));
    la[320 + lane] = e5;
    if (l == 0) {
#pragma unroll
      for (int j = 0; j < 8; ++j) {
        const int c = lane + 64 * j;
        p.VF[(size_t)row * 512 + c] = f2bf(mix(C_V + c, mu[C_V + c]));
      }
    }
  }
}

__device__ void phase_prep(const Params& p, int l, char* smem) {
  const int nk = (l == 1) ? 4 : 3;
  for (int k = 0;; ++k) {
    int mt, kn;
    if (!next_tile(k, 128, 2 * nk, mt, kn)) break;
    const int kind = kn >> 1, nt = kn & 1;
    const int koff = kind == 0 ? 0 : (kind == 1 ? 64 : (kind == 2 ? 128 : 320));
    const int Kk = kind == 2 ? 192 : 64;
    const u16* Wk = kind == 0 ? p.w2T : (kind == 1 ? p.a2T : (kind == 2 ? p.g2T : p.v2T));
    f32x4 acc[8][4];
    zero_acc<4>(acc);
    gemm_core<4>(acc, p.LA + (size_t)mt * 256 * LALD + koff, LALD, Wk + (size_t)nt * 256 * Kk, Kk, Kk, smem);
    const int m0 = mt * 256, n0 = nt * 256;
    if (kind == 0) {
      const float* w0 = p.rw_w0 + l * 512 + n0;
      epilogue_bf16<4>(acc, smem, p.WR + (size_t)m0 * 512 + n0, 512, [&](int, int col, f32x4 v) {
        const f32x4 b = *(const f32x4*)(w0 + col);
        f32x4 o = {v[0] + b[0], v[1] + b[1], v[2] + b[2], v[3] + b[3]};
        return o;
      });
    } else if (kind == 1) {
      const float* a0 = p.rw_a0 + l * 512 + n0;
      epilogue_bf16<4>(acc, smem, p.AA + (size_t)m0 * 512 + n0, 512, [&](int, int col, f32x4 v) {
        const f32x4 b = *(const f32x4*)(a0 + col);
        f32x4 o = {sigmoidf_(v[0] + b[0]), sigmoidf_(v[1] + b[1]), sigmoidf_(v[2] + b[2]), sigmoidf_(v[3] + b[3])};
        return o;
      });
    } else if (kind == 2) {
      epilogue_bf16<4>(acc, smem, p.GG + (size_t)m0 * 512 + n0, 512, [&](int, int, f32x4 v) { return v; });
    } else {
      const float* v0 = p.vres_v0 + n0;
      const float* mu = p.rw_mu + l * 1824 + C_V + n0;
      epilogue<4>(acc, smem, [&](int row, int col, f32x4 v) {
        const int m = m0 + row;
        const bool hp = (m & (SEQ - 1)) != 0;
        const u16* pr = p.PROJ + (size_t)m * PLD + C_V + n0 + col;
        u16* vf = p.VF + (size_t)m * 512 + n0 + col;
        f32x4 o;
#pragma unroll
        for (int j = 0; j < 4; ++j) {
          const float a = bf2f(pr[j]);
          const float b = hp ? bf2f(pr[j - PLD]) : 0.f;
          const float vv = a + (b - a) * mu[col + j];
          const float gate = sigmoidf_(v0[col + j] + v[j]);
          const float f = bf2f(vf[j]);
          o[j] = vv + (f - vv) * gate;
        }
        store_bf4(vf, o);
      });
    }
  }
}

__device__ void rwkv_item(const Params& p, int l, int item, char* smem, int dry) {
  const int b = item >> 3, hh = item & 7;
  const int tid = TIDX, lane = tid & 63, wave = tid >> 6;
  float* stg = (float*)smem;
  float* ybuf = stg + 2 * 16 * 448;
  float* bon = ybuf + 16 * 4 * 64;
  const int col = hh * 64 + lane;
  const float mu_r = p.rw_mu[l * 1824 + C_R + col], mu_k = p.rw_mu[l * 1824 + C_K + col];
  const float kk_w = p.rw_k_k[l * 512 + col], ka_w = p.rw_k_a[l * 512 + col], rk_w = p.rw_r_k[l * 512 + col];
  const float gnw = p.rw_gn_w[l * 512 + col], gnb = p.rw_gn_b[l * 512 + col];
  const size_t row0 = (size_t)b * SEQ;
  const int r0 = wave * 8 + (lane >> 4) * 2, c = lane & 15;
  f32x2 Sa[2], Sb[2];
#pragma unroll
  for (int i = 0; i < 2; ++i) { Sa[i] = f32x2{0.f, 0.f}; Sb[i] = f32x2{0.f, 0.f}; }
  u16 q_rt[2], q_rp[2], q_kt[2], q_kp[2], q_v[2], q_a[2], q_w[2], q_g[2];
#define RW_LOAD(t0)                                                                                 \
  {                                                                                                 \
    int pin_ = 1;                                                                                   \
    asm volatile("" : "+s"(pin_));                                                                  \
    _Pragma("unroll") for (int i = 0; i < 2; ++i) {                                                 \
      q_rt[i] = 0; q_kt[i] = 0; q_rp[i] = 0; q_kp[i] = 0; q_v[i] = 0; q_a[i] = 0; q_w[i] = 0; q_g[i] = 0; \
    }                                                                                               \
    if (pin_) {                                                                                     \
    _Pragma("unroll") for (int i = 0; i < 2; ++i) {                                                 \
      const int t = (t0) + wave + 8 * i;                                                            \
      const size_t row = row0 + t;                                                                  \
      const u16* pr = p.PROJ + row * PLD;                                                           \
      q_rt[i] = pr[C_R + col]; q_kt[i] = pr[C_K + col];                                             \
      q_rp[i] = t > 0 ? pr[C_R + col - PLD] : (u16)0; q_kp[i] = t > 0 ? pr[C_K + col - PLD] : (u16)0; \
      q_v[i] = p.VF[row * 512 + col]; q_a[i] = p.AA[row * 512 + col];                               \
      q_w[i] = p.WR[row * 512 + col]; q_g[i] = p.GG[row * 512 + col];                               \
    }                                                                                               \
    }                                                                                               \
  }
#define RW_FILL(buf)                                                                                \
  {                                                                                                 \
    _Pragma("unroll") for (int i = 0; i < 2; ++i) {                                                 \
      const int tt = wave + 8 * i;                                                                  \
      const float rt = bf2f(q_rt[i]), kt_ = bf2f(q_kt[i]);                                          \
      const float r = rt + (bf2f(q_rp[i]) - rt) * mu_r;                                             \
      const float kx = kt_ + (bf2f(q_kp[i]) - kt_) * mu_k;                                          \
      const float aa = bf2f(q_a[i]);                                                                \
      const float kkv = kx * kk_w;                                                                  \
      const float nrm = sqrtf(wave_sum(kkv * kkv));                                                 \
      const float kkn = kkv / fmaxf(nrm, 1e-12f);                                                   \
      const float knew = kx * (1.f + (aa - 1.f) * ka_w);                                            \
      const float wl = -softplusf_(-bf2f(q_w[i])) - 0.5f;                                           \
      const float wdec = __expf(-__expf(wl));                                                       \
      float* s = stg + ((buf) * 16 + tt) * 448;                                                     \
      s[lane] = r; s[64 + lane] = wdec; s[128 + lane] = knew; s[192 + lane] = -kkn;                 \
      s[256 + lane] = kkn * aa; s[320 + lane] = bf2f(q_v[i]); s[384 + lane] = bf2f(q_g[i]);         \
      const float bs = wave_sum(r * knew * rk_w);                                                   \
      if (lane == 0) bon[(buf) * 16 + tt] = bs;                                                     \
    }                                                                                               \
  }
  __syncthreads();
  RW_LOAD(0);
  RW_FILL(0);
  __syncthreads();
  for (int ch = 0; ch < SEQ / 16; ++ch) {
    const int buf = ch & 1, t0 = ch * 16;
    {
    if (ch + 1 < SEQ / 16) RW_LOAD(t0 + 16);
    {
      f32x4 op[2][5];
      f32x2 ov[2];
      const float* sb = stg + buf * 16 * 448 + c * 4;
#define RW_LDOPS(tt, q)                                                        \
      {                                                                        \
        const float* s_ = sb + (tt) * 448;                                     \
        _Pragma("unroll") for (int u = 0; u < 5; ++u) op[q][u] = *(const f32x4*)(s_ + 64 * u); \
        ov[q] = *(const f32x2*)(stg + (buf * 16 + (tt)) * 448 + 320 + r0);     \
      }
#define PK_LO(v) __builtin_shufflevector((v), (v), 0, 1)
#define PK_HI(v) __builtin_shufflevector((v), (v), 2, 3)
      RW_LDOPS(0, 0);
#pragma unroll 1
      for (int t2 = 0; t2 < 16; t2 += 2) {
#pragma unroll
      for (int q = 0; q < 2; ++q) {
        const int tt = t2 + q;
        if (q == 0) RW_LDOPS(tt + 1, 1) else if (t2 + 2 < 16) RW_LDOPS(tt + 1, 0);
        f32x2 sA = Sa[0] * PK_LO(op[q][3]); sA += Sa[1] * PK_HI(op[q][3]);
        f32x2 sB = Sb[0] * PK_LO(op[q][3]); sB += Sb[1] * PK_HI(op[q][3]);
        const float saa = red16(sA[0] + sA[1]);
        const float sab = red16(sB[0] + sB[1]);
        const f32x2 saa2 = {saa, saa}, sab2 = {sab, sab};
        const f32x2 va2 = {ov[q][0], ov[q][0]}, vb2 = {ov[q][1], ov[q][1]};
        Sa[0] = Sa[0] * PK_LO(op[q][1]) + saa2 * PK_LO(op[q][4]) + va2 * PK_LO(op[q][2]);
        Sa[1] = Sa[1] * PK_HI(op[q][1]) + saa2 * PK_HI(op[q][4]) + va2 * PK_HI(op[q][2]);
        Sb[0] = Sb[0] * PK_LO(op[q][1]) + sab2 * PK_LO(op[q][4]) + vb2 * PK_LO(op[q][2]);
        Sb[1] = Sb[1] * PK_HI(op[q][1]) + sab2 * PK_HI(op[q][4]) + vb2 * PK_HI(op[q][2]);
        f32x2 yA = Sa[0] * PK_LO(op[q][0]); yA += Sa[1] * PK_HI(op[q][0]);
        f32x2 yB = Sb[0] * PK_LO(op[q][0]); yB += Sb[1] * PK_HI(op[q][0]);
        const float ya = red4(yA[0] + yA[1]);
        const float yb = red4(yB[0] + yB[1]);
        if ((c & 3) == 0) { f32x2 yy = {ya, yb}; *(f32x2*)(ybuf + (tt * 4 + (c >> 2)) * 64 + r0) = yy; }
      }
      }
#undef RW_LDOPS
    }
    }
    __syncthreads();
    {
#pragma unroll
    for (int i = 0; i < 2; ++i) {
      const int tt = wave + 8 * i;
      const float y = (ybuf[(tt * 4) * 64 + lane] + ybuf[(tt * 4 + 1) * 64 + lane]) + (ybuf[(tt * 4 + 2) * 64 + lane] + ybuf[(tt * 4 + 3) * 64 + lane]);
      const float mean = wave_sum(y) * (1.f / 64.f);
      const float d = y - mean;
      const float var = wave_sum(d * d) * (1.f / 64.f);
      const float yn = d * rsqrtf(var + 64e-5f) * gnw + gnb;
      const float* s = stg + (buf * 16 + tt) * 448;
      const float o = (yn + bon[buf * 16 + tt] * s[320 + lane]) * s[384 + lane];
      if (!dry) p.GG[(row0 + t0 + tt) * 512 + col] = f2bf(o);
    }
    if (ch + 1 < SEQ / 16) RW_FILL(buf ^ 1);
    }
    __syncthreads();
  }
#undef RW_LOAD
#undef RW_FILL
}

__device__ void ssd_item(const Params& p, int l, int item, char* smem, int dry) {
  const int b = item >> 3, hh = item & 7, g = hh >> 2;
  const int tid = TIDX, lane = tid & 63, wave = tid >> 6;
  constexpr int SS = 456;
  float* stg = (float*)smem;
  float* ybuf = stg + 2 * 16 * SS;
  int chn[5] = {hh * 64 + lane, 512 + g * 128 + lane, 512 + g * 128 + 64 + lane, 768 + g * 128 + lane, 768 + g * 128 + 64 + lane};
  float cw[4][5], cbv[5];
#pragma unroll
  for (int k = 0; k < 5; ++k) {
    cbv[k] = p.conv_b[l * 1024 + chn[k]];
#pragma unroll
    for (int j = 0; j < 4; ++j) cw[j][k] = p.conv_w[(l * 4 + j) * 1024 + chn[k]];
  }
  const float dtb = p.dt_bias[l * 8 + hh];
  const float Aneg = -__expf(p.a_log[l * 8 + hh]);
  const float Dsk = p.ssm_d[l * 8 + hh];
  const size_t row0 = (size_t)b * SEQ;
  const int r0 = wave * 8 + (lane >> 4) * 2, c = lane & 15;
  f32x2 Sa[4], Sb[4];
#pragma unroll
  for (int i = 0; i < 4; ++i) { Sa[i] = f32x2{0.f, 0.f}; Sb[i] = f32x2{0.f, 0.f}; }
  u16 q_x[5][5], q_z[2], q_dt[2];
#define SSD_LOAD(t0)                                                                   \
  {                                                                                    \
    _Pragma("unroll") for (int k = 0; k < 5; ++k) {                                    \
      const int t = (t0) + 2 * wave - 3 + k;                                           \
      const u16* pr = p.PROJ + (row0 + (t < 0 ? 0 : t)) * PLD + C_XBC;                 \
      _Pragma("unroll") for (int j = 0; j < 5; ++j) q_x[k][j] = t >= 0 ? pr[chn[j]] : (u16)0; \
    }                                                                                  \
    int pin_ = 1;                                                                      \
    asm volatile("" : "+s"(pin_));                                                     \
    q_z[0] = 0; q_z[1] = 0; q_dt[0] = 0; q_dt[1] = 0;                                  \
    if (pin_) {                                                                        \
    _Pragma("unroll") for (int i = 0; i < 2; ++i) {                                    \
      const u16* pr = p.PROJ + (row0 + (t0) + 2 * wave + i) * PLD;                     \
      q_z[i] = pr[C_Z + hh * 64 + lane]; q_dt[i] = pr[C_DT + hh];                      \
    }                                                                                  \
    }                                                                                  \
  }
#define SSD_FILL(buf)                                                                  \
  {                                                                                    \
    _Pragma("unroll") for (int i = 0; i < 2; ++i) {                                    \
      float cv[5];                                                                     \
      _Pragma("unroll") for (int j = 0; j < 5; ++j) {                                  \
        float a = cbv[j];                                                              \
        _Pragma("unroll") for (int k = 0; k < 4; ++k) a += cw[k][j] * bf2f(q_x[i + k][j]); \
        cv[j] = siluf_(a);                                                             \
      }                                                                                \
      const float dt = softplusf_(bf2f(q_dt[i]) + dtb);                                \
      float* s = stg + ((buf) * 16 + 2 * wave + i) * SS;                               \
      s[lane] = cv[1]; s[64 + lane] = cv[2]; s[128 + lane] = cv[3]; s[192 + lane] = cv[4]; \
      s[256 + lane] = cv[0] * dt; s[320 + lane] = cv[0]; s[384 + lane] = bf2f(q_z[i]); \
      if (lane == 0) s[448] = __expf(dt * Aneg);                                       \
    }                                                                                  \
  }
  __syncthreads();
  SSD_LOAD(0);
  SSD_FILL(0);
  __syncthreads();
  for (int ch = 0; ch < SEQ / 16; ++ch) {
    const int buf = ch & 1, t0 = ch * 16;
    {
    if (ch + 1 < SEQ / 16) SSD_LOAD(t0 + 16);
    {
      f32x4 op[2][4];
      f32x2 oxd[2];
      float oda[2];
      const float* sb = stg + buf * 16 * SS;
#define SSD_LDOPS(tt, q)                                                       \
      {                                                                        \
        const float* s_ = sb + (tt) * SS;                                      \
        oda[q] = s_[448];                \
        oxd[q] = *(const f32x2*)(s_ + 256 + r0);                               \
        op[q][0] = *(const f32x4*)(s_ + c * 8);                                \
        op[q][1] = *(const f32x4*)(s_ + c * 8 + 4);                            \
        op[q][2] = *(const f32x4*)(s_ + 128 + c * 8);                          \
        op[q][3] = *(const f32x4*)(s_ + 128 + c * 8 + 4);                      \
      }
      SSD_LDOPS(0, 0);
#pragma unroll 1
      for (int t2 = 0; t2 < 16; t2 += 2) {
#pragma unroll
      for (int q = 0; q < 2; ++q) {
        const int tt = t2 + q;
        if (q == 0) SSD_LDOPS(tt + 1, 1) else if (t2 + 2 < 16) SSD_LDOPS(tt + 1, 0);
        const f32x2 dA2 = {oda[q], oda[q]};
        const f32x2 xa2 = {oxd[q][0], oxd[q][0]}, xb2 = {oxd[q][1], oxd[q][1]};
        const f32x2 B2[4] = {PK_LO(op[q][0]), PK_HI(op[q][0]), PK_LO(op[q][1]), PK_HI(op[q][1])};
        const f32x2 C2[4] = {PK_LO(op[q][2]), PK_HI(op[q][2]), PK_LO(op[q][3]), PK_HI(op[q][3])};
        f32x2 yA = {0.f, 0.f}, yB = {0.f, 0.f};
#pragma unroll
        for (int j = 0; j < 4; ++j) {
          Sa[j] = Sa[j] * dA2 + xa2 * B2[j];
          Sb[j] = Sb[j] * dA2 + xb2 * B2[j];
          yA += Sa[j] * C2[j];
          yB += Sb[j] * C2[j];
        }
        const float ya = red4(yA[0] + yA[1]);
        const float yb = red4(yB[0] + yB[1]);
        if ((c & 3) == 0) { f32x2 yy = {ya, yb}; *(f32x2*)(ybuf + (tt * 4 + (c >> 2)) * 64 + r0) = yy; }
      }
      }
#undef SSD_LDOPS
    }
    }
    __syncthreads();
    {
#pragma unroll
    for (int i = 0; i < 2; ++i) {
      const int tt = wave + 8 * i;
      const float* s = stg + (buf * 16 + tt) * SS;
      const float y = ((ybuf[(tt * 4) * 64 + lane] + ybuf[(tt * 4 + 1) * 64 + lane]) + (ybuf[(tt * 4 + 2) * 64 + lane] + ybuf[(tt * 4 + 3) * 64 + lane])) + Dsk * s[320 + lane];
      const float zz = s[384 + lane];
      if (!dry) p.PROJ[(row0 + t0 + tt) * PLD + C_Z + hh * 64 + lane] = f2bf(y * siluf_(zz));
    }
    if (ch + 1 < SEQ / 16) SSD_FILL(buf ^ 1);
    }
    __syncthreads();
  }
#undef SSD_LOAD
#undef SSD_FILL
}

__device__ void attn_item(const Params& p, int l, int item, char* smem, int dry) {
  const int hp = item & 3, qb = (item >> 2) & 15, b = item >> 6;
  const int kvh = hp >> 1;
  u16* Ks = (u16*)smem;
  u16* Vt = (u16*)(smem + 256 * 72 * 2);
  float* invd = (float*)(smem + 256 * 72 * 2 + 64 * 264 * 2);
  const int tid = TIDX, lane = tid & 63, wave = tid >> 6, wq = wave & 3, l31 = lane & 31, h = lane >> 5;
  const int hq = hp * 2 + (wave >> 2);
  const size_t rowq0 = (size_t)b * SEQ + qb * 128;
  const long rowk0 = (long)rowq0 - 128;
  __syncthreads();
#pragma unroll
  for (int i = 0; i < 4; ++i) {
    const int cidx = tid + NTHR * i;
    const int key = cidx >> 3, cc = cidx & 7;
    uint4 v = {0u, 0u, 0u, 0u};
    if (qb > 0 || key >= 128) v = *(const uint4*)(p.PROJ + (size_t)(rowk0 + key) * PLD + C_AK + kvh * 64 + cc * 8);
    *(uint4*)(Ks + key * 72 + cc * 8) = v;
  }
#pragma unroll
  for (int i = 0; i < 4; ++i) {
    const int key = (tid & 63) + 64 * i;
    const int dc = tid >> 6;
    uint4 v = {0u, 0u, 0u, 0u};
    if (qb > 0 || key >= 128) v = *(const uint4*)(p.PROJ + (size_t)(rowk0 + key) * PLD + C_AV + kvh * 64 + dc * 8);
    const unsigned e[4] = {v.x, v.y, v.z, v.w};
#pragma unroll
    for (int j = 0; j < 4; ++j) {
      Vt[(dc * 8 + 2 * j) * 264 + key] = (u16)(e[j] & 0xffffu);
      Vt[(dc * 8 + 2 * j + 1) * 264 + key] = (u16)(e[j] >> 16);
    }
  }
  __syncthreads();
  const u16* qptr = p.PROJ + (rowq0 + wq * 32 + l31) * PLD + C_Q + hq * 64 + h * 8;
  bf16x8 qf[4];
#pragma unroll
  for (int ks = 0; ks < 4; ++ks) qf[ks] = *(const bf16x8*)(qptr + ks * 16);
  f32x16 sc[5];
#pragma unroll
  for (int i = 0; i < 5; ++i) {
#pragma unroll
    for (int r = 0; r < 16; ++r) sc[i][r] = 0.f;
    const u16* kp = Ks + ((wq + i) * 32 + l31) * 72 + h * 8;
#pragma unroll
    for (int ks = 0; ks < 4; ++ks) {
      const bf16x8 kf = *(const bf16x8*)(kp + ks * 16);
      sc[i] = MFMA(kf, qf[ks], sc[i]);
    }
  }
  const int qi = wq * 32 + l31;
  const float sink = p.sinks[l * 8 + hq];
  float m = sink;
#pragma unroll
  for (int i = 0; i < 5; ++i)
#pragma unroll
    for (int r = 0; r < 16; ++r) {
      const int j = (wq + i) * 32 + crow(r, h);
      const int rel = qi + 128 - j;
      const bool valid = (rel >= 0) && (rel < 128) && (qb > 0 || j >= 128);
      const float s = valid ? sc[i][r] * 0.125f : -INFINITY;
      sc[i][r] = s;
      m = fmaxf(m, s);
    }
  m = fmaxf(m, __shfl_xor(m, 32));
  float sum = 0.f;
#pragma unroll
  for (int i = 0; i < 5; ++i)
#pragma unroll
    for (int r = 0; r < 16; ++r) {
      const float pv = __expf(sc[i][r] - m);
      sc[i][r] = pv;
      sum += pv;
    }
  sum += __shfl_xor(sum, 32);
  const float denom = sum + __expf(sink - m);
  if (h == 0) invd[(wave >> 2) * 128 + qi] = 1.f / denom;
  f32x16 o[2];
#pragma unroll
  for (int db = 0; db < 2; ++db)
#pragma unroll
    for (int r = 0; r < 16; ++r) o[db][r] = 0.f;
#pragma unroll
  for (int i = 0; i < 5; ++i)
#pragma unroll
    for (int s2 = 0; s2 < 2; ++s2) {
      bf16x8 pa;
#pragma unroll
      for (int j = 0; j < 8; ++j) pa[j] = (short)f2bf(sc[i][8 * s2 + j]);
#pragma unroll
      for (int db = 0; db < 2; ++db) {
        const u16* vp = Vt + (db * 32 + l31) * 264 + (wq + i) * 32 + 16 * s2 + 4 * h;
        const s16x4 lo = *(const s16x4*)vp;
        const s16x4 hi = *(const s16x4*)(vp + 8);
        const bf16x8 vf = __builtin_shufflevector(lo, hi, 0, 1, 2, 3, 4, 5, 6, 7);
        o[db] = MFMA(pa, vf, o[db]);
      }
    }
  __syncthreads();
#pragma unroll
  for (int db = 0; db < 2; ++db)
#pragma unroll
    for (int r = 0; r < 16; ++r) {
      const int q = wq * 32 + crow(r, h);
      if (!dry) p.PROJ[(rowq0 + q) * PLD + C_Q + hq * 64 + db * 32 + l31] = f2bf(o[db][r] * invd[(wave >> 2) * 128 + q]);
    }
}

__device__ void phase_attn(const Params& p, int l, char* smem, int dry) {
  for (int it = BIDX; it < 1024; it += GDIM) attn_item(p, l, it, smem, dry);
}
__device__ void phase_mix(const Params& p, int l, char* smem, int dry) {
  for (int it = BIDX; it < 256; it += GDIM) {
    if (it < 128) rwkv_item(p, l, it, smem, dry);
    else ssd_item(p, l, it - 128, smem, dry);
  }
}

__device__ void phase_post(const Params& p, int l, char* smem) {
  cvt_T(p.w_gu + (size_t)l * DM * 2 * FH, 1024, 2 * FH, 0, 2 * FH, p.WguT, XLD, 0, 1, smem);
  cvt_T(p.w_down + (size_t)l * FH * DM, FH, 1024, 0, 1024, p.WdownT, FH, 0, 0, smem);
  const int lane = TIDX & 63;
  const int gw = BIDX * NWV + (TIDX >> 6), nw = GDIM * NWV;
  const float* nwp = p.ssm_norm_w + l * 512 + lane * 8;
  for (int row = gw; row < M_TOK; row += nw) {
    u16* pz = p.PROJ + (size_t)row * PLD + C_Z + lane * 8;
    const uint4 raw = *(const uint4*)pz;
    const unsigned e[4] = {raw.x, raw.y, raw.z, raw.w};
    float v[8];
    float ss = 0.f;
#pragma unroll
    for (int j = 0; j < 4; ++j) {
      v[2 * j] = bf2f((u16)(e[j] & 0xffffu));
      v[2 * j + 1] = bf2f((u16)(e[j] >> 16));
      ss += v[2 * j] * v[2 * j] + v[2 * j + 1] * v[2 * j + 1];
    }
#pragma unroll
    for (int o = 16; o > 0; o >>= 1) ss += __shfl_xor(ss, o);
    const float rstd = rsqrtf(ss * (1.f / 256.f) + 1e-6f);
    uint4 ov;
    ov.x = pack2(v[0] * rstd * nwp[0], v[1] * rstd * nwp[1]);
    ov.y = pack2(v[2] * rstd * nwp[2], v[3] * rstd * nwp[3]);
    ov.z = pack2(v[4] * rstd * nwp[4], v[5] * rstd * nwp[5]);
    ov.w = pack2(v[6] * rstd * nwp[6], v[7] * rstd * nwp[7]);
    *(uint4*)pz = ov;
  }
}

__device__ void phase_G2(const Params& p, int l, char* smem) {
  const int lane = TIDX & 63, wave = TIDX >> 6, wn = wave & 1, fq = lane >> 4;
  u32x4 ra[4], rw[2];
  bool pre = false;
  int mt, nt;
  bool have = next_tile(0, 128, 8, mt, nt);
  for (int k = 0; have; ++k) {
    int mt2 = 0, nt2 = 0;
    const bool have2 = next_tile(k + 1, 128, 8, mt2, nt2);
    const int m0 = mt * 256, n0 = nt * 128;
    f32x4 tot[4][4];
    zero_acc<2>(tot);
#pragma unroll 1
    for (int br = 0; br < 3; ++br) {
      const u16* Ab; int lda;
      if (br == 0) { Ab = p.GG + (size_t)m0 * 512; lda = 512; }
      else if (br == 1) { Ab = p.PROJ + (size_t)m0 * PLD + C_Z; lda = PLD; }
      else { Ab = p.PROJ + (size_t)m0 * PLD + C_Q; lda = PLD; }
      const u16* Wb = p.WbrT + ((size_t)br * 1024 + n0) * 512;
      f32x4 ac[4][4];
      zero_acc<2>(ac);
      gemm_core<2>(ac, p.XN + (size_t)m0 * XLD, XLD, p.WgT + ((size_t)br * 1024 + n0) * XLD, XLD, DM, smem, ra, rw, pre,
                   Ab, lda, Wb, 512);
      unsigned sg[4][4][2];
      const float* gb = p.gate_b + l * 3072 + br * 1024 + n0 + wn * 64 + fq * 4;
#pragma unroll
      for (int nb = 0; nb < 4; ++nb) {
        const f32x4 bias = *(const f32x4*)(gb + nb * 16);
#pragma unroll
        for (int mb = 0; mb < 4; ++mb) {
          sg[nb][mb][0] = cvt_pk_bf16(sigmoidf_(ac[nb][mb][0] + bias[0]), sigmoidf_(ac[nb][mb][1] + bias[1]));
          sg[nb][mb][1] = cvt_pk_bf16(sigmoidf_(ac[nb][mb][2] + bias[2]), sigmoidf_(ac[nb][mb][3] + bias[3]));
        }
      }
      zero_acc<2>(ac);
      const bool more = br < 2 || have2;
      const int m0n = br < 2 ? m0 : mt2 * 256, n0n = br < 2 ? n0 : nt2 * 128, brn = br < 2 ? br + 1 : 0;
      gemm_core<2>(ac, Ab, lda, Wb, 512, 512, smem, ra, rw, true,
                   more ? p.XN + (size_t)m0n * XLD : nullptr, XLD, p.WgT + ((size_t)brn * 1024 + n0n) * XLD, XLD);
      pre = more;
#pragma unroll
      for (int nb = 0; nb < 4; ++nb)
#pragma unroll
        for (int mb = 0; mb < 4; ++mb) {
          tot[nb][mb][0] += __uint_as_float(sg[nb][mb][0] << 16) * ac[nb][mb][0];
          tot[nb][mb][1] += __uint_as_float(sg[nb][mb][0] & 0xffff0000u) * ac[nb][mb][1];
          tot[nb][mb][2] += __uint_as_float(sg[nb][mb][1] << 16) * ac[nb][mb][2];
          tot[nb][mb][3] += __uint_as_float(sg[nb][mb][1] & 0xffff0000u) * ac[nb][mb][3];
        }
    }
    u16* dst = p.MERGED + (size_t)m0 * DM + n0;
    epilogue_bf16<2>(tot, smem, dst, DM, [&](int, int, f32x4 v) { return v; });
    mt = mt2; nt = nt2; have = have2;
  }
}

__device__ void phase_resid(const Params& p, const u16* A, int K, const u16* W, int ldw, char* smem, int dry) {
  for (int k = 0;; ++k) {
    int mt, nt;
    if (!next_tile(k, 128, 4, mt, nt)) break;
    f32x4 acc[8][4];
    zero_acc<4>(acc);
    gemm_core<4>(acc, A + (size_t)mt * 256 * K, K, W + (size_t)nt * 256 * ldw, ldw, K, smem);
    float* dst = p.out + (size_t)mt * 256 * DM + nt * 256;
    epilogue<4>(acc, smem, [&](int row, int col, f32x4 v) {
      f32x4* px = (f32x4*)(dst + (size_t)row * DM + col);
      f32x4 x = *px;
      x[0] += v[0]; x[1] += v[1]; x[2] += v[2]; x[3] += v[3];
      if (!dry) *px = x;
    });
  }
}

__device__ void phase_G4(const Params& p, char* smem) {
  u32x4 ra[4], rw[4];
  bool pre = false;
  int mt, nt;
  bool have = next_tile(0, 128, 22, mt, nt);
  for (int k = 0; have; ++k) {
    int mt2 = 0, nt2 = 0;
    const bool have2 = next_tile(k + 1, 128, 22, mt2, nt2);
    f32x4 acc[8][4];
    zero_acc<4>(acc);
    gemm_core<4>(acc, p.XN + (size_t)mt * 256 * XLD, XLD, p.WguT + (size_t)nt * 256 * XLD, XLD, DM, smem, ra, rw, pre,
                 have2 ? p.XN + (size_t)mt2 * 256 * XLD : nullptr, XLD, p.WguT + (size_t)nt2 * 256 * XLD, XLD);
    pre = have2;
    f32x4 hv[4][4];
#pragma unroll
    for (int pb = 0; pb < 4; ++pb) {
      const int nbg = (pb >> 1) * 4 + (pb & 1);
#pragma unroll
      for (int mb = 0; mb < 4; ++mb)
#pragma unroll
        for (int j = 0; j < 4; ++j) hv[pb][mb][j] = siluf_(acc[nbg][mb][j]) * acc[nbg + 2][mb][j];
    }
    u16* dst = p.H + (size_t)mt * 256 * FH + nt * 128;
    epilogue_bf16<2>(hv, smem, dst, FH, [&](int, int, f32x4 v) { return v; });
    mt = mt2; nt = nt2; have = have2;
  }
}

__device__ void phase_final(const Params& p) { rmsnorm_rows(p.out, p.norm_final, nullptr, p.out); }

DI void grid_barrier(unsigned* bar, unsigned target) {
  __syncthreads();
  if (TIDX == 0) {
    __threadfence();
    __hip_atomic_fetch_add(bar, 1u, __ATOMIC_RELAXED, __HIP_MEMORY_SCOPE_AGENT);
    while (__hip_atomic_load(bar, __ATOMIC_RELAXED, __HIP_MEMORY_SCOPE_AGENT) < target) __builtin_amdgcn_s_sleep(4);
    __threadfence();
  }
  __syncthreads();
}

#define XB_TMO      128
#define XB_XCNT(j)  (256  + 64 * (j))
#define XB_XSUB(j)  (1280 + 64 * (j))
#define XB_XGEN(j)  (2304 + 64 * (j))
#define XB_TOP      3328
#define XB_TOPGEN   3392
#define XCD_BAR_WORDS 3456
#define XB_SPIN_CAP (1u << 20)
#define LAS __attribute__((address_space(3)))
DI unsigned xb_ld(unsigned* p) { return __hip_atomic_load(p, __ATOMIC_RELAXED, __HIP_MEMORY_SCOPE_AGENT); }
DI unsigned xb_add(unsigned* p, unsigned v) { return __hip_atomic_fetch_add(p, v, __ATOMIC_RELAXED, __HIP_MEMORY_SCOPE_AGENT); }
DI unsigned xb_xcc_id() { return (unsigned)__builtin_amdgcn_s_getreg((3 << 11) | 20) & 0xFu; }
#define XB_SPIN(cond, bar) do { unsigned _sp = 0; while (cond) { __builtin_amdgcn_s_sleep(1); \
    if ((++_sp & 255u) == 0u) { if (xb_ld(&(bar)[XB_TMO])) break; if (_sp > XB_SPIN_CAP) { atomicAdd(&(bar)[XB_TMO], 1u); break; } } } } while (0)
DI void xcd_barrier_post(unsigned* bar) {
  if (threadIdx.x == 0) (void)xb_add(&bar[XB_XCNT(xb_xcc_id())], 1u);
}
DI void xcd_barrier_complete(unsigned* bar, unsigned x, unsigned& nloc, unsigned& nx) {
  const unsigned G = gridDim.x;
  unsigned sum, cnt, mine, sp = 0u;
  for (;;) {
    sum = 0u; cnt = 0u; mine = 0u;
#pragma unroll
    for (unsigned j = 0; j < 16; ++j) { const unsigned c = xb_ld(&bar[XB_XCNT(j)]); sum += c; cnt += (c > 0u) ? 1u : 0u; mine = (j == x) ? c : mine; }
    if (sum == G) break;
    __builtin_amdgcn_s_sleep(1);
    if ((++sp & 255u) == 0u) { if (xb_ld(&bar[XB_TMO])) break; if (sp > XB_SPIN_CAP) { atomicAdd(&bar[XB_TMO], 1u); break; } }
  }
  nloc = mine > 0u ? mine : 1u; nx = cnt > 0u ? cnt : 1u;
}
DI void xcd_barrier(unsigned* bar, volatile LAS unsigned* st) {
  asm volatile("s_waitcnt vmcnt(0)" ::: "memory");
  __syncthreads();
  if (threadIdx.x == 0) {
    __builtin_amdgcn_s_waitcnt(0);
    const unsigned x = xb_xcc_id();
    unsigned nloc = st[0], nx = st[1];
    if (nloc == 0u) { xcd_barrier_complete(bar, x, nloc, nx); st[0] = nloc; st[1] = nx; }
    const unsigned old = xb_add(&bar[XB_XSUB(x)], 1u);
    const unsigned gen = old / nloc;
    if (old + 1u == (gen + 1u) * nloc) {
      __builtin_amdgcn_fence(__ATOMIC_RELEASE, "agent");
      asm volatile("s_waitcnt vmcnt(0)" ::: "memory");
      const unsigned og = xb_add(&bar[XB_TOP], 1u);
      const unsigned tg = og / nx;
      if (og + 1u == (tg + 1u) * nx) xb_add(&bar[XB_TOPGEN], 1u);
      else XB_SPIN(xb_ld(&bar[XB_TOPGEN]) == tg, bar);
      __builtin_amdgcn_fence(__ATOMIC_ACQUIRE, "agent");
      xb_add(&bar[XB_XGEN(x)], 1u);
      asm volatile("s_waitcnt vmcnt(0)" ::: "memory");
    } else {
      XB_SPIN(xb_ld(&bar[XB_XGEN(x)]) == gen, bar);
      __builtin_amdgcn_fence(__ATOMIC_ACQUIRE, "agent");
      asm volatile("s_waitcnt vmcnt(0)" ::: "memory");
    }
  }
  __syncthreads();
}

constexpr int NPH = 12;
DI void run_phase(const Params& p, int l, int ph, char* smem, int dry = 0) {
  asm volatile("" : "+s"(l));
  switch (ph) {
    case 0: phase_A(p, l, smem); break;
    case 1: phase_G1(p, smem); break;
    case 2: phase_pre(p, l); break;
    case 3: phase_prep(p, l, smem); break;
    case 4: phase_mix(p, l, smem, dry); break;
    case 11: phase_attn(p, l, smem, dry); break;
    case 5: phase_post(p, l, smem); break;
    case 6: phase_G2(p, l, smem); break;
    case 7: phase_resid(p, p.MERGED, DM, p.WoutT, XLD, smem, dry); break;
    case 8: rmsnorm_rows(p.out, p.norm_ffn + l * DM, p.XN, nullptr); break;
    case 9: phase_G4(p, smem); break;
    case 10: phase_resid(p, p.H, FH, p.WdownT, FH, smem, dry); break;
    default: break;
  }
}

#if MULTI
template <int PH>
__global__ void __launch_bounds__(NTHR) k_phase(Params p, int l) {
  __shared__ __attribute__((aligned(16))) char smem[SMEM_BYTES];
  if (PH < NPH) run_phase(p, l, PH, smem);
  else phase_final(p);
}
#else
__global__ void __launch_bounds__(NTHR) k_mega(Params p) {
  __shared__ __attribute__((aligned(16))) char smem[SMEM_BYTES];
  cg::grid_group grid = cg::this_grid();
  __shared__ uint4 xb_words;
  if (threadIdx.x == 0) xb_words = make_uint4(0u, 0u, 0u, 0u);
  __syncthreads();
  unsigned* bar = (unsigned*)p.ctr;
  if (blockIdx.x == 0) for (int i = threadIdx.x; i < XCD_BAR_WORDS; i += NTHR) bar[i] = 0u;
  for (int l = 0; l < 2; ++l) {
#pragma unroll 1
    for (int i = 0; i < NPH; ++i) {
      const int ph = i < 4 ? i : (i == 4 ? 11 : i - 1);
      run_phase(p, l, ph, smem);
      if (l == 0 && i == 0) { grid.sync(); xcd_barrier_post(bar); }
      else xcd_barrier(bar, (volatile LAS unsigned*)&xb_words);
    }
  }
  phase_final(p);
}
#endif

extern "C" void kernel_launch(void* const* d_in, const int* in_sizes, int n_in, void* d_out, int out_size, void* d_ws, size_t ws_size,
                              hipStream_t stream) {
  Params p{};
  const float** pf = (const float**)&p;
  for (int i = 0; i < 34; ++i) pf[i] = (const float*)d_in[i];
  p.out = (float*)d_out;
  char* ws = (char*)d_ws;
  size_t off = 0;
  auto take = [&](size_t bytes) { char* r = ws + off; off += (bytes + 255) & ~(size_t)255; return r; };
  p.ctr = (int*)take(16384);
  p.WinT = (u16*)take((size_t)PLD * XLD * 2);
  p.WgT = (u16*)take((size_t)3072 * XLD * 2);
  p.WbrT = (u16*)take((size_t)3 * 1024 * 512 * 2);
  p.WoutT = (u16*)take((size_t)1024 * XLD * 2);
  p.w2T = (u16*)take(512 * 64 * 2);
  p.a2T = (u16*)take(512 * 64 * 2);
  p.g2T = (u16*)take(512 * 192 * 2);
  p.v2T = (u16*)take(512 * 64 * 2);
  char* shared = take((size_t)M_TOK * LALD * 2);
  p.LA = (u16*)shared;
  p.WguT = (u16*)shared;
  p.WdownT = (u16*)(shared + (size_t)2 * FH * XLD * 2);
  p.XN = (u16*)take((size_t)M_TOK * XLD * 2);
  p.PROJ = (u16*)take((size_t)M_TOK * PLD * 2);
  p.H = p.PROJ;
  p.VF = (u16*)take((size_t)M_TOK * 512 * 2);
  p.AA = (u16*)take((size_t)M_TOK * 512 * 2);
  p.WR = (u16*)take((size_t)M_TOK * 512 * 2);
  p.GG = (u16*)take((size_t)M_TOK * 512 * 2);
  p.MERGED = p.AA;
  if (off > ws_size || n_in != 34) { fprintf(stderr, "kernel_launch: workspace too small (%zu needed, %zu given) or n_in %d\n", off, ws_size, n_in); return; }
#if MULTI
#define LP(PH) hipLaunchKernelGGL(k_phase<PH>, dim3(256), dim3(NTHR), 0, stream, p, l)
  for (int l = 0; l < 2; ++l) { LP(0); LP(1); LP(2); LP(3); LP(11); LP(4); LP(5); LP(6); LP(7); LP(8); LP(9); LP(10); }
  { int l = 0; LP(12); }
#else
  static int grid = 0;
  if (!grid) {
    int dev = 0, cus = 0, per_cu = 0;
    hipGetDevice(&dev);
    hipDeviceGetAttribute(&cus, hipDeviceAttributeMultiprocessorCount, dev);
    (void)hipOccupancyMaxActiveBlocksPerMultiprocessor(&per_cu, k_mega, NTHR, 0);
    if (per_cu < 1) per_cu = 1;
    if (per_cu > 1) per_cu = 1;
    grid = cus * per_cu;
  }
  void* args[] = {&p};
  hipError_t e = hipLaunchCooperativeKernel((void*)k_mega, dim3(grid), dim3(NTHR), args, 0, stream);
  if (e != hipSuccess) fprintf(stderr, "cooperative launch failed: %s (grid %d)\n", hipGetErrorString(e), grid);
#endif
}
```
